# Optimizing an MI355X kernel written in HIP

```python
import jax
import jax.numpy as jnp
from jax import lax
import numpy as np

D_MODEL = 1024
BATCH = 4
SEQ = 4096
DEPTH = 4

CTX_LEN = 256
GRID_W = 64
HEAD_DIM = 64
CONV_WIDTH = 256
CONV_K = 3
RET_HEADS = 4
RET_WIDTH = RET_HEADS * HEAD_DIM
RET_CHUNK = 128
ATTN_HEADS = 8
ATTN_KV_HEADS = 2
ATTN_GROUP = ATTN_HEADS // ATTN_KV_HEADS
ATTN_WIDTH = ATTN_HEADS * HEAD_DIM
KV_WIDTH = ATTN_KV_HEADS * HEAD_DIM
WINDOW = 128
BLOCK = 128
MIX_WIDTH = CONV_WIDTH + RET_WIDTH + ATTN_WIDTH
SPLIT_SIZES = (CONV_WIDTH,) * 3 + (RET_WIDTH,) * 5 + (ATTN_WIDTH, KV_WIDTH, KV_WIDTH)
SPLIT_IDX = tuple(sum(SPLIT_SIZES[:i + 1]) for i in range(len(SPLIT_SIZES) - 1))
IN_WIDTH = sum(SPLIT_SIZES)
N_EXPERTS = 16
CAPACITY_FACTOR = 2
D_EXPERT = 1024
ROPE_BASE = 10000.0
EPS = 1e-6
NEG_INF = -1e30

kernel_name = 'hybrid_parallel_group_dit'


def rms_norm(x, g):
    xf = x.astype(jnp.float32)
    y = xf * lax.rsqrt(jnp.mean(xf * xf, axis=-1, keepdims=True) + EPS)
    return (y * g.astype(jnp.float32)).astype(x.dtype)


def head_norm(o):
    of = o.astype(jnp.float32)
    mu = jnp.mean(of, axis=-1, keepdims=True)
    var = jnp.mean(jnp.square(of - mu), axis=-1, keepdims=True)
    return ((of - mu) * lax.rsqrt(var + EPS)).astype(o.dtype)


def modulate(h, shift, scale):
    return h * (1.0 + scale) + shift


def axial_rope_tables(n_tokens):
    rows = n_tokens // GRID_W
    row = jnp.repeat(jnp.arange(rows, dtype=jnp.float32), GRID_W)
    col = jnp.tile(jnp.arange(GRID_W, dtype=jnp.float32), rows)
    axis_dim = HEAD_DIM // 2
    inv_freq = ROPE_BASE ** (-jnp.arange(0, axis_dim, 2, dtype=jnp.float32) / axis_dim)
    ang = jnp.stack([row[:, None] * inv_freq, col[:, None] * inv_freq], axis=1)
    return jnp.cos(ang), jnp.sin(ang)


def apply_axial_rope(x, cos, sin):
    shp = x.shape
    xr = x.astype(jnp.float32).reshape(shp[:-1] + (2, 2, HEAD_DIM // 4))
    x1, x2 = xr[..., 0, :], xr[..., 1, :]
    out = jnp.stack([x1 * cos - x2 * sin, x2 * cos + x1 * sin], axis=-2)
    return out.reshape(shp).astype(x.dtype)


def to_heads(t, n_heads):
    b, n, _ = t.shape
    return t.reshape(b, n, n_heads, HEAD_DIM).transpose(0, 2, 1, 3)


def from_heads(t):
    b, h, n, d = t.shape
    return t.transpose(0, 2, 1, 3).reshape(b, n, h * d)


def gated_short_conv(gate_b, gate_c, u, conv_w):
    z = jnp.pad(gate_c * u, ((0, 0), (1, 1), (0, 0)))
    conv = z[:, :-2] * conv_w[0] + z[:, 1:-1] * conv_w[1] + z[:, 2:] * conv_w[2]
    return gate_b * conv


def retention_states(k, v, log_g, s0):
    b, h, n_tok, d = k.shape
    n_chunk = n_tok // RET_CHUNK
    kc = k.reshape(b, h, n_chunk, RET_CHUNK, d)
    vc = v.reshape(b, h, n_chunk, RET_CHUNK, d)
    j = jnp.arange(RET_CHUNK, dtype=jnp.float32)
    w_in = jnp.exp(log_g[:, None] * (RET_CHUNK - 1 - j))
    u = jnp.einsum('bhnld,bhnle,hl->bhnde', kc, vc, w_in).astype(jnp.float32)
    chunk_decay = jnp.exp(log_g * RET_CHUNK)[:, None, None]

    def step(s, u_n):
        return chunk_decay * s + u_n, s

    s_fin, s_prev = lax.scan(step, s0, jnp.moveaxis(u, 2, 0))
    return jnp.moveaxis(s_prev, 0, 2), s_fin


def retention_readout(q, k, v, log_g, s_prev):
    b, h, n_tok, d = q.shape
    n_chunk = n_tok // RET_CHUNK
    qc = q.reshape(b, h, n_chunk, RET_CHUNK, d)
    kc = k.reshape(b, h, n_chunk, RET_CHUNK, d)
    vc = v.reshape(b, h, n_chunk, RET_CHUNK, d)
    i = jnp.arange(RET_CHUNK, dtype=jnp.float32)
    diff = i[:, None] - i[None, :]
    dmask = jnp.where(diff >= 0, jnp.exp(log_g[:, None, None] * jnp.maximum(diff, 0.0)), 0.0)
    scores = jnp.einsum('bhnid,bhnjd->bhnij', qc, kc) * dmask[:, None]
    o = jnp.einsum('bhnij,bhnje->bhnie', scores, vc)
    q_dec = jnp.exp(log_g[:, None] * (i + 1.0))
    o = o + jnp.einsum('bhnid,bhnde,hi->bhnie', qc, s_prev, q_dec)
    return o.reshape(b, h, n_tok, d).astype(q.dtype)


def window_context_attention(q, k, v, k_ctx, v_ctx, sink):
    b, h, g, n_tok, d = q.shape
    nb = n_tok // BLOCK
    scale = d ** -0.5
    qb = q.reshape(b, h, g, nb, BLOCK, d)
    pad = ((0, 0), (0, 0), (BLOCK, BLOCK), (0, 0))
    kp = jnp.pad(k, pad).reshape(b, h, nb + 2, BLOCK, d)
    vp = jnp.pad(v, pad).reshape(b, h, nb + 2, BLOCK, d)
    kw = jnp.concatenate([kp[:, :, :-2], kp[:, :, 1:-1], kp[:, :, 2:]], axis=3)
    vw = jnp.concatenate([vp[:, :, :-2], vp[:, :, 1:-1], vp[:, :, 2:]], axis=3)
    s_win = jnp.einsum('bhgnqd,bhnkd->bhgnqk', qb, kw).astype(jnp.float32) * scale
    q_pos = jnp.arange(n_tok).reshape(nb, BLOCK)
    k_pos = (jnp.arange(nb) * BLOCK - BLOCK)[:, None] + jnp.arange(3 * BLOCK)[None, :]
    rel = q_pos[:, :, None] - k_pos[:, None, :]
    valid = (jnp.abs(rel) <= WINDOW) & (k_pos[:, None, :] >= 0) & (k_pos[:, None, :] < n_tok)
    s_win = jnp.where(valid, s_win, NEG_INF)
    s_ctx = jnp.einsum('bhgnqd,bhkd->bhgnqk', qb, k_ctx).astype(jnp.float32) * scale
    s_sink = jnp.broadcast_to(sink.astype(jnp.float32)[None, :, :, None, None, None], s_ctx.shape[:-1] + (1,))
    p = jax.nn.softmax(jnp.concatenate([s_win, s_ctx, s_sink], axis=-1), axis=-1).astype(v.dtype)
    n_win = 3 * BLOCK
    n_ctx = k_ctx.shape[2]
    o = (jnp.einsum('bhgnqk,bhnkd->bhgnqd', p[..., :n_win], vw)
         + jnp.einsum('bhgnqk,bhkd->bhgnqd', p[..., n_win:n_win + n_ctx], v_ctx))
    return o.reshape(b, h, g, n_tok, d)


def context_attention(q, k, v, sink):
    scale = q.shape[-1] ** -0.5
    s = jnp.einsum('bhgqd,bhkd->bhgqk', q, k).astype(jnp.float32) * scale
    s_sink = jnp.broadcast_to(sink.astype(jnp.float32)[None, :, :, None, None], s.shape[:-1] + (1,))
    p = jax.nn.softmax(jnp.concatenate([s, s_sink], axis=-1), axis=-1)[..., :-1].astype(v.dtype)
    return jnp.einsum('bhgqk,bhkd->bhgqd', p, v)


def expert_choice_ffn(h, w_router, w_gate, w_up, w_down):
    n_tok, d_model = h.shape[1], h.shape[2]
    cap = CAPACITY_FACTOR * n_tok // N_EXPERTS
    aff = jax.nn.softmax((h @ w_router).astype(jnp.float32), axis=-1)
    gate, idx = lax.top_k(jnp.swapaxes(aff, 1, 2), cap)
    xs = jax.vmap(lambda hb, ib: hb[ib])(h, idx)
    a = jnp.einsum('becd,edf->becf', xs, w_gate)
    u = jnp.einsum('becd,edf->becf', xs, w_up)
    y = jnp.einsum('becf,efd->becd', jax.nn.silu(a) * u, w_down) * gate[..., None].astype(h.dtype)

    def scatter(ib, yb):
        return jnp.zeros((n_tok, d_model), yb.dtype).at[ib.reshape(-1)].add(yb.reshape(-1, d_model))

    return jax.vmap(scatter)(idx, y)


def token_mixer(h_lat, h_ctx, w_in, conv_w, ret_logit, sink, w_out, cos, sin, need_ctx):
    b = h_lat.shape[0]
    (cb_l, cc_l, cx_l, rq_l, rk_l, rv_l, rgf_l, rgb_l, aq_l, ak_l, av_l) = jnp.split(h_lat @ w_in, SPLIT_IDX, axis=-1)
    (cb_c, cc_c, cx_c, rq_c, rk_c, rv_c, rgf_c, rgb_c, aq_c, ak_c, av_c) = jnp.split(h_ctx @ w_in, SPLIT_IDX, axis=-1)
    k_scale = HEAD_DIM ** -0.5

    conv_l = gated_short_conv(cb_l, cc_l, cx_l, conv_w)

    q_l = apply_axial_rope(to_heads(rq_l, RET_HEADS), cos, sin)
    k_l = apply_axial_rope(to_heads(rk_l, RET_HEADS) * k_scale, cos, sin)
    v_l = to_heads(rv_l, RET_HEADS)
    k_c = to_heads(rk_c, RET_HEADS) * k_scale
    v_c = to_heads(rv_c, RET_HEADS)
    q_c = to_heads(rq_c, RET_HEADS) if need_ctx else None
    gates_l = (rgf_l, rgb_l)
    gates_c = (rgf_c, rgb_c)
    s_zero = jnp.zeros((b, RET_HEADS, HEAD_DIM, HEAD_DIM), jnp.float32)
    ret_l = 0.0
    ret_c = 0.0
    for d in range(2):
        log_g = jax.nn.log_sigmoid(ret_logit[d].astype(jnp.float32))
        fl = (lambda t: jnp.flip(t, axis=2)) if d == 1 else (lambda t: t)
        sp_c, s_c = retention_states(fl(k_c), fl(v_c), log_g, s_zero)
        sp_l, _ = retention_states(fl(k_l), fl(v_l), log_g, s_c)
        o_l = fl(retention_readout(fl(q_l), fl(k_l), fl(v_l), log_g, sp_l))
        ret_l = ret_l + from_heads(head_norm(o_l)) * jax.nn.silu(gates_l[d])
        if need_ctx:
            o_c = fl(retention_readout(fl(q_c), fl(k_c), fl(v_c), log_g, sp_c))
            ret_c = ret_c + from_heads(head_norm(o_c)) * jax.nn.silu(gates_c[d])

    n_tok = h_lat.shape[1]
    qa_l = apply_axial_rope(to_heads(aq_l, ATTN_HEADS), cos, sin).reshape(b, ATTN_KV_HEADS, ATTN_GROUP, n_tok, HEAD_DIM)
    ka_l = apply_axial_rope(to_heads(ak_l, ATTN_KV_HEADS), cos, sin)
    va_l = to_heads(av_l, ATTN_KV_HEADS)
    ka_c = to_heads(ak_c, ATTN_KV_HEADS)
    va_c = to_heads(av_c, ATTN_KV_HEADS)
    sink_hg = sink.reshape(ATTN_KV_HEADS, ATTN_GROUP)
    attn_l = window_context_attention(qa_l, ka_l, va_l, ka_c, va_c, sink_hg)
    attn_l = from_heads(attn_l.reshape(b, ATTN_HEADS, n_tok, HEAD_DIM))
    y_l = jnp.concatenate([conv_l, ret_l, attn_l], axis=-1) @ w_out
    if not need_ctx:
        return y_l, None

    n_ctx = h_ctx.shape[1]
    conv_c = gated_short_conv(cb_c, cc_c, cx_c, conv_w)
    qa_c = to_heads(aq_c, ATTN_HEADS).reshape(b, ATTN_KV_HEADS, ATTN_GROUP, n_ctx, HEAD_DIM)
    attn_c = context_attention(qa_c, ka_c, va_c, sink_hg)
    attn_c = from_heads(attn_c.reshape(b, ATTN_HEADS, n_ctx, HEAD_DIM))
    y_c = jnp.concatenate([conv_c, ret_c, attn_c], axis=-1) @ w_out
    return y_l, y_c


def setup_inputs(seed: int = 0) -> dict:
    key = jax.random.key(seed)
    ks = jax.random.split(key, 18)
    f32 = jnp.float32

    def nrm(k, shape, s):
        return jax.random.normal(k, shape, f32) * s

    ret_base = jnp.log(jnp.exp2(5.0 + jnp.arange(RET_HEADS, dtype=f32)) - 1.0)
    return {
        'x': nrm(ks[0], (BATCH, SEQ, D_MODEL), 1.0),
        'c': nrm(ks[1], (BATCH, D_MODEL), 1.0),
        'ctx': nrm(ks[2], (BATCH, CTX_LEN, D_MODEL), 1.0),
        'c_ctx': nrm(ks[3], (D_MODEL,), 1.0),
        'w_mod': nrm(ks[4], (DEPTH, D_MODEL, 6 * D_MODEL), 0.5 * D_MODEL ** -0.5),
        'b_mod': nrm(ks[5], (DEPTH, 6 * D_MODEL), 0.02),
        'norm1_g': 1.0 + nrm(ks[6], (DEPTH, D_MODEL), 0.02),
        'norm2_g': 1.0 + nrm(ks[7], (DEPTH, D_MODEL), 0.02),
        'w_in': nrm(ks[8], (DEPTH, D_MODEL, IN_WIDTH), D_MODEL ** -0.5),
        'conv_w': nrm(ks[9], (DEPTH, CONV_K, CONV_WIDTH), CONV_K ** -0.5),
        'ret_decay_logit': ret_base + nrm(ks[10], (DEPTH, 2, RET_HEADS), 0.1),
        'attn_sink': nrm(ks[11], (DEPTH, ATTN_HEADS), 0.5),
        'w_out': nrm(ks[12], (DEPTH, MIX_WIDTH, D_MODEL), MIX_WIDTH ** -0.5),
        'w_router': nrm(ks[13], (DEPTH, D_MODEL, N_EXPERTS), D_MODEL ** -0.5),
        'w_gate': nrm(ks[14], (DEPTH, N_EXPERTS, D_MODEL, D_EXPERT), D_MODEL ** -0.5),
        'w_up': nrm(ks[15], (DEPTH, N_EXPERTS, D_MODEL, D_EXPERT), D_MODEL ** -0.5),
        'w_down': nrm(ks[16], (DEPTH, N_EXPERTS, D_EXPERT, D_MODEL), D_EXPERT ** -0.5),
        'final_g': 1.0 + nrm(ks[17], (D_MODEL,), 0.02),
    }


def reference(x, c, ctx, c_ctx, w_mod, b_mod, norm1_g, norm2_g, w_in, conv_w, ret_decay_logit,
              attn_sink, w_out, w_router, w_gate, w_up, w_down, final_g):
    cos, sin = axial_rope_tables(x.shape[1])
    silu_c = jax.nn.silu(c)
    silu_cc = jax.nn.silu(c_ctx)
    for l in range(DEPTH):
        need_ctx = l < DEPTH - 1
        mod_l = (silu_c @ w_mod[l] + b_mod[l])[:, None, :]
        mod_c = (silu_cc @ w_mod[l] + b_mod[l])[None, None, :]
        sh1, sc1, g1, sh2, sc2, g2 = jnp.split(mod_l, 6, axis=-1)
        csh1, csc1, cg1, csh2, csc2, cg2 = jnp.split(mod_c, 6, axis=-1)

        h_l = modulate(rms_norm(x, norm1_g[l]), sh1, sc1)
        h_c = modulate(rms_norm(ctx, norm1_g[l]), csh1, csc1)
        y_l, y_c = token_mixer(h_l, h_c, w_in[l], conv_w[l], ret_decay_logit[l], attn_sink[l],
                               w_out[l], cos, sin, need_ctx)
        x = x + g1 * y_l
        h_l = modulate(rms_norm(x, norm2_g[l]), sh2, sc2)
        x = x + g2 * expert_choice_ffn(h_l, w_router[l], w_gate[l], w_up[l], w_down[l])
        if need_ctx:
            ctx = ctx + cg1 * y_c
            h_c = modulate(rms_norm(ctx, norm2_g[l]), csh2, csc2)
            ctx = ctx + cg2 * expert_choice_ffn(h_c, w_router[l], w_gate[l], w_up[l], w_down[l])
    return rms_norm(x, final_g)
```

```cpp
#include <hip/hip_runtime.h>
#include <hip/hip_cooperative_groups.h>
#include <cstdio>
#include <cstdint>

#ifndef FFN_FP8
#define FFN_FP8 1
#endif
#ifndef MK_PER_PHASE
#define MK_PER_PHASE 0
#endif

#define GAS __attribute__((address_space(1)))
#define LAS __attribute__((address_space(3)))
typedef unsigned short bf16_t;
typedef short bf16x8 __attribute__((ext_vector_type(8)));
typedef float f32x4 __attribute__((ext_vector_type(4)));
typedef float f32x2 __attribute__((ext_vector_type(2)));
typedef unsigned u32x4 __attribute__((ext_vector_type(4)));
typedef unsigned u32x2 __attribute__((ext_vector_type(2)));
typedef __bf16 bf16x2_t __attribute__((ext_vector_type(2)));

constexpr int D = 1024, BATCH = 4, SEQ = 4096, DEPTH = 4, CTXL = 256;
constexpr int NLAT = BATCH * SEQ, NCTX = BATCH * CTXL, MROWS = NLAT + NCTX;
constexpr int INW = 2816;
constexpr int C_CB = 0, C_CC = 256, C_CX = 512, C_RQ = 768, C_RK = 1024, C_RV = 1280, C_RGF = 1536, C_RGB = 1792, C_AQ = 2048, C_AK = 2560, C_AV = 2688;
constexpr int NE = 16, CAP_L = 512, CAP_C = 32, EROWS = 2304;
constexpr int NCHUNK = 34;
constexpr float EPS = 1e-6f;
constexpr float LOG2E = 1.4426950408889634f;

constexpr size_t MiB = 1u << 20;
constexpr size_t WS_CTL = 0, CTL_ZERO_BYTES = 512 * 1024;
constexpr size_t WS_MOD = 1 * MiB;
constexpr size_t WS_ROPE = 1 * MiB + 512 * 1024;
constexpr size_t WS_AFF = 2 * MiB;
constexpr size_t WS_ROWS = 4 * MiB;
constexpr size_t WS_GATE = 4 * MiB + 256 * 1024;
constexpr size_t WS_INV = 5 * MiB;
constexpr size_t WS_X = 8 * MiB;
constexpr size_t WS_H = 76 * MiB;
constexpr size_t WS_PROJ = 110 * MiB;
constexpr size_t WS_MIX = 204 * MiB;
constexpr size_t WS_U = 238 * MiB;
constexpr size_t WS_ST = 256 * MiB;
constexpr size_t WS_ACT = 266 * MiB;
constexpr size_t WS_YB = 338 * MiB;
constexpr size_t WS_WIN = 410 * MiB;
constexpr size_t WS_WOUT = 432 * MiB;
constexpr size_t WS_WGU = 440 * MiB;
constexpr size_t WS_WD = 696 * MiB;
constexpr size_t WS_X1 = 824 * MiB;
constexpr size_t WS_END = 892 * MiB;
constexpr int CW_BAR = 4096;

constexpr int RING_BYTES = 131072;
constexpr int LDSCTL_OFF = RING_BYTES, MISC_OFF = LDSCTL_OFF + 320;
constexpr int LDS_BYTES = 147456;
constexpr int NWAVES = 8, NTHREADS = 512;

__device__ __forceinline__ unsigned pk2(float lo, float hi) { f32x2 v = {lo, hi}; bf16x2_t b = __builtin_convertvector(v, bf16x2_t); return __builtin_bit_cast(unsigned, b); }
__device__ __forceinline__ float bflo(unsigned w) { return __uint_as_float(w << 16); }
__device__ __forceinline__ float bfhi(unsigned w) { return __uint_as_float(w & 0xffff0000u); }
__device__ __forceinline__ float fexp2(float x) { return __builtin_amdgcn_exp2f(x); }
__device__ __forceinline__ float fexp(float x) { return __builtin_amdgcn_exp2f(x * LOG2E); }
__device__ __forceinline__ float silu_f(float x) { return x / (1.0f + __expf(-x)); }
__device__ __forceinline__ float shx(float v, int o, int lane) { return __uint_as_float((unsigned)__builtin_amdgcn_ds_bpermute((lane ^ o) << 2, (int)__float_as_uint(v))); }
__device__ __forceinline__ int shxi(int v, int o, int lane) { return __builtin_amdgcn_ds_bpermute((lane ^ o) << 2, v); }
__device__ __forceinline__ float sum_x32(float v) { auto r = __builtin_amdgcn_permlane32_swap(__float_as_uint(v), __float_as_uint(v), false, false); return __uint_as_float(r[0]) + __uint_as_float(r[1]); }
__device__ __forceinline__ float sum_x16(float v) { auto r = __builtin_amdgcn_permlane16_swap(__float_as_uint(v), __float_as_uint(v), false, false); return __uint_as_float(r[0]) + __uint_as_float(r[1]); }
__device__ __forceinline__ float max_x32(float v) { auto r = __builtin_amdgcn_permlane32_swap(__float_as_uint(v), __float_as_uint(v), false, false); return fmaxf(__uint_as_float(r[0]), __uint_as_float(r[1])); }
__device__ __forceinline__ float max_x16(float v) { auto r = __builtin_amdgcn_permlane16_swap(__float_as_uint(v), __float_as_uint(v), false, false); return fmaxf(__uint_as_float(r[0]), __uint_as_float(r[1])); }
__device__ __forceinline__ float wave_sum(float v, int lane) {
    v += shx(v, 1, lane); v += shx(v, 2, lane); v += shx(v, 4, lane); v += shx(v, 8, lane); v = sum_x16(v); v = sum_x32(v);
    return v;
}
#define LDS_WAIT() asm volatile("s_waitcnt lgkmcnt(0)" ::: "memory")
#define VM_WAIT() asm volatile("s_waitcnt vmcnt(0)" ::: "memory")

#define XB_TMO      128
#define XB_XCNT(j)  (256  + 64 * (j))
#define XB_XSUB(j)  (1280 + 64 * (j))
#define XB_XGEN(j)  (2304 + 64 * (j))
#define XB_TOP      3328
#define XB_TOPGEN   3392
#define XCD_BAR_WORDS 3456
#define XB_SPIN_CAP (1u << 22)
__device__ __forceinline__ unsigned xb_ld(unsigned* p)              { return __hip_atomic_load(p, __ATOMIC_RELAXED, __HIP_MEMORY_SCOPE_AGENT); }
__device__ __forceinline__ unsigned xb_add(unsigned* p, unsigned v) { return __hip_atomic_fetch_add(p, v, __ATOMIC_RELAXED, __HIP_MEMORY_SCOPE_AGENT); }
__device__ __forceinline__ unsigned xb_xcc_id() { return (unsigned)__builtin_amdgcn_s_getreg((3 << 11) | 20) & 0xFu; }
#define XB_SPIN(cond, bar) do { unsigned _sp = 0; while (cond) { __builtin_amdgcn_s_sleep(1); \
    if ((++_sp & 255u) == 0u) { if (xb_ld(&(bar)[XB_TMO])) break; if (_sp > XB_SPIN_CAP) { atomicAdd(&(bar)[XB_TMO], 1u); break; } } } } while (0)
struct XcdBarrier { unsigned* bar; unsigned x; volatile LAS unsigned* st; };
__device__ __forceinline__ XcdBarrier xcd_barrier_post(unsigned* bar, volatile LAS unsigned* st, bool leader) {
    XcdBarrier b; b.bar = bar; b.x = xb_xcc_id(); b.st = st;
    if (leader) (void)xb_add(&bar[XB_XCNT(b.x)], 1u);
    return b;
}
__device__ __forceinline__ void xcd_barrier_complete(unsigned* bar, unsigned x, unsigned& nloc, unsigned& nx) {
    const unsigned G = gridDim.x * gridDim.y * gridDim.z;
    unsigned sum, cnt, mine, sp = 0u;
    for (;;) {
        sum = 0u; cnt = 0u; mine = 0u;
#pragma unroll
        for (unsigned j = 0; j < 16; ++j) { const unsigned c = xb_ld(&bar[XB_XCNT(j)]); sum += c; cnt += (c > 0u) ? 1u : 0u; mine = (j == x) ? c : mine; }
        if (sum == G) break;
        __builtin_amdgcn_s_sleep(1);
        if ((++sp & 255u) == 0u) { if (xb_ld(&bar[XB_TMO])) break; if (sp > XB_SPIN_CAP) { atomicAdd(&bar[XB_TMO], 1u); break; } }
    }
    nloc = mine > 0u ? mine : 1u; nx = cnt > 0u ? cnt : 1u;
}
__device__ __forceinline__ void xcd_barrier(const XcdBarrier& b, bool leader) {
    asm volatile("s_waitcnt vmcnt(0)" ::: "memory");
    __syncthreads();
    if (leader) {
        unsigned* bar = b.bar;
        __builtin_amdgcn_s_waitcnt(0);
        unsigned nloc = b.st[0], nx = b.st[1];
        if (nloc == 0u) { xcd_barrier_complete(bar, b.x, nloc, nx); b.st[0] = nloc; b.st[1] = nx; }
        const unsigned old = xb_add(&bar[XB_XSUB(b.x)], 1u);
        const unsigned gen = old / nloc;
        if (old + 1u == (gen + 1u) * nloc) {
            __builtin_amdgcn_fence(__ATOMIC_RELEASE, "agent");
            asm volatile("s_waitcnt vmcnt(0)" ::: "memory");
            const unsigned og = xb_add(&bar[XB_TOP], 1u);
            const unsigned tg = og / nx;
            if (og + 1u == (tg + 1u) * nx) xb_add(&bar[XB_TOPGEN], 1u);
            else XB_SPIN(xb_ld(&bar[XB_TOPGEN]) == tg, bar);
            __builtin_amdgcn_fence(__ATOMIC_ACQUIRE, "agent");
            xb_add(&bar[XB_XGEN(b.x)], 1u);
            asm volatile("s_waitcnt vmcnt(0)" ::: "memory");
        } else {
            XB_SPIN(xb_ld(&bar[XB_XGEN(b.x)]) == gen, bar);
            __builtin_amdgcn_fence(__ATOMIC_ACQUIRE, "agent");
            asm volatile("s_waitcnt vmcnt(0)" ::: "memory");
        }
    }
    __syncthreads();
}

namespace pg8 {
constexpr int BM = 256, BK = 64, HALF = 128, HTB = HALF * BK * 2, STAGE_BYTES = 8 * HTB, NXCD = 8, WGM = 8;
__host__ __device__ __forceinline__ int lds_byte(int r, int c) { const int st = (r >> 4) * 2 + (c >> 5), rr = r & 15, cc = c & 31, ob = rr * 64 + cc * 2; return st * 1024 + (ob ^ (((ob >> 9) & 1) << 5)); }
__host__ __device__ __forceinline__ void stage_rc(int b, int& R, int& C) { const int st = b / 1024, sb = b % 1024, swz = sb ^ (((sb >> 9) & 1) << 5); R = (st >> 1) * 16 + swz / 64; C = (st & 1) * 32 + (swz % 64) / 2; }
__host__ __device__ __forceinline__ int perm32(int rho) { const int n = rho >> 4, i = rho & 15; return 8 * (i >> 2) + 4 * n + (i & 3); }
struct Unit { int pm, pn, e, t; };
typedef int v4i_t __attribute__((ext_vector_type(4)));
typedef int v8i_t __attribute__((ext_vector_type(8)));

template <class Epi, class Sched>
__device__ __forceinline__ void gemm_phase(LAS unsigned char* lds, const int tid, const int K, const Sched& S, const Epi& E) {
    const int wid = __builtin_amdgcn_readfirstlane(tid >> 6), lane = tid & 63, wr = wid >> 2, wc = wid & 3, fr = lane & 15, fq = lane >> 4;
    const int nt = K / BK;
    int Rr[2]; unsigned cb[2], voffB[2];
#pragma unroll
    for (int i = 0; i < 2; ++i) { int R, C; stage_rc(tid * 16 + i * 8192, R, C); Rr[i] = R; cb[i] = (unsigned)C * 2u; const int Rb = Epi::PERM ? ((R & ~31) + perm32(R & 31)) : R; voffB[i] = (unsigned)(Rb * K + C) * 2u; }
    const size_t kstep = (size_t)(BK * 2);
    const size_t hstep = (size_t)HALF * K * 2;
    const unsigned rowb = (unsigned)K * 2u;
    const unsigned ldsw = (unsigned)wid * 1024u;
    const int aoff = lds_byte(wr * 64 + fr, fq * 8), boff = lds_byte(wc * 32 + fr, fq * 8);
#define PG8_SA(b, h) (((b) * 2 + (h)) * HTB)
#define PG8_SB(b, h) ((4 + (b) * 2 + (h)) * HTB)
#define PG8_STAGE(bufoff, gbase, voff) do { _Pragma("unroll") for (int _i = 0; _i < 2; ++_i) \
        __builtin_amdgcn_global_load_lds((const unsigned*)((const char*)(gbase) + (voff)[_i]), (LAS unsigned*)(lds + (bufoff) + ldsw + _i * 8192), 16, 0, 0); } while (0)
#define PG8_LDA(dst, b, h) do { if constexpr (Epi::FP8) { _Pragma("unroll") for (int m = 0; m < 4; ++m) dst##8[m] = __builtin_shufflevector(*(const LAS v4i_t*)(lds + PG8_SA(b, h) + aoff + m * 2048), *(const LAS v4i_t*)(lds + PG8_SA(b, h) + aoff + m * 2048 + 1024), 0, 1, 2, 3, 4, 5, 6, 7); } \
        else { _Pragma("unroll") for (int m = 0; m < 4; ++m) _Pragma("unroll") for (int k = 0; k < 2; ++k) dst[m][k] = *(const LAS bf16x8*)(lds + PG8_SA(b, h) + aoff + m * 2048 + k * 1024); } } while (0)
#define PG8_LDB(dst, b, h) do { if constexpr (Epi::FP8) { _Pragma("unroll") for (int n = 0; n < 2; ++n) dst##8[n] = __builtin_shufflevector(*(const LAS v4i_t*)(lds + PG8_SB(b, h) + boff + n * 2048), *(const LAS v4i_t*)(lds + PG8_SB(b, h) + boff + n * 2048 + 1024), 0, 1, 2, 3, 4, 5, 6, 7); } \
        else { _Pragma("unroll") for (int n = 0; n < 2; ++n) _Pragma("unroll") for (int k = 0; k < 2; ++k) dst[n][k] = *(const LAS bf16x8*)(lds + PG8_SB(b, h) + boff + n * 2048 + k * 1024); } } while (0)
#define PG8_MMA(ai, bj, At, Bt) do { __builtin_amdgcn_s_setprio(1); \
        if constexpr (Epi::FP8) { _Pragma("unroll") for (int m = 0; m < 4; ++m) _Pragma("unroll") for (int n = 0; n < 2; ++n) \
            asm volatile("v_mfma_scale_f32_16x16x128_f8f6f4 %0, %1, %2, %0, %3, %3 op_sel_hi:[0,0,0]" : "+v"(acc[ai][bj][m][n]) : "v"(Bt##8[n]), "v"(At##8[m]), "v"(sc1v)); } \
        else { _Pragma("unroll") for (int m = 0; m < 4; ++m) _Pragma("unroll") for (int n = 0; n < 2; ++n) _Pragma("unroll") for (int k = 0; k < 2; ++k) \
            acc[ai][bj][m][n] = __builtin_amdgcn_mfma_f32_16x16x32_bf16(Bt[n][k], At[m][k], acc[ai][bj][m][n], 0, 0, 0); } \
        __builtin_amdgcn_s_setprio(0); } while (0)
#define PG8_WAIT_V(n) asm volatile("s_waitcnt vmcnt(" #n ")" ::: "memory")
#define PG8_WAIT_L(n) asm volatile("s_waitcnt lgkmcnt(" #n ")" ::: "memory")
#define PG8_BAR __builtin_amdgcn_s_barrier()
#define PG8_SCHED __builtin_amdgcn_sched_barrier(0)
#define PG8_AOFFS(u, o0, o1) do { _Pragma("unroll") for (int _i = 0; _i < 2; ++_i) { o0[_i] = (unsigned)S.arow(u, Rr[_i]) * rowb + cb[_i]; o1[_i] = (unsigned)S.arow(u, HALF + Rr[_i]) * rowb + cb[_i]; } } while (0)
    Unit cur, nxt, pu; int ui = 0; bool pend = false;
    if (!S.next(0, cur)) return;
    pu = cur;
    f32x4 acc[2][2][4][2];
#pragma unroll
    for (int a = 0; a < 2; ++a)
#pragma unroll
        for (int b = 0; b < 2; ++b)
#pragma unroll
            for (int m = 0; m < 4; ++m)
#pragma unroll
                for (int n = 0; n < 2; ++n) acc[a][b][m][n] = (f32x4){0.f, 0.f, 0.f, 0.f};
    bf16x8 At[4][2], B0[2][2], B1[2][2];
    v8i_t At8[4], B08[2], B18[2];
    int sc1v = 0x7f7f7f7f; asm volatile("" : "+v"(sc1v));
    unsigned c0[2], c1[2], n0[2], n1[2];
    S.a_ready(cur, tid);
    PG8_AOFFS(cur, c0, c1);
    const char* cB = S.bbase(cur); const char* cA = S.abase(cur);
    PG8_STAGE(PG8_SB(0, 0), cB, voffB); PG8_STAGE(PG8_SB(0, 1), cB + hstep, voffB); PG8_STAGE(PG8_SA(0, 0), cA, c0); PG8_STAGE(PG8_SA(0, 1), cA, c1);
    if (wr == 1) PG8_BAR;
    PG8_WAIT_V(2); PG8_BAR;
    PG8_STAGE(PG8_SB(1, 0), cB + kstep, voffB); PG8_STAGE(PG8_SA(1, 0), cA + kstep, c0); PG8_STAGE(PG8_SB(1, 1), cB + hstep + kstep, voffB);
    PG8_WAIT_V(6); PG8_BAR;
    for (;;) {
        const bool has_next = S.next(ui + 1, nxt);
        const char* nB = cB; const char* nA = cA;
        if (has_next) { PG8_AOFFS(nxt, n0, n1); nB = S.bbase(nxt); nA = S.abase(nxt); }
        else {
#pragma unroll
            for (int i = 0; i < 2; ++i) { n0[i] = c0[i]; n1[i] = c1[i]; }
        }
        for (int t = 0; t < nt; t += 2) {
            const bool last = (t == nt - 2);
            if (last && has_next) S.a_ready(nxt, tid);
            const char* a1 = cA + (size_t)(t + 1) * kstep;
            const char* a2 = last ? nA : cA + (size_t)(t + 2) * kstep; const char* b2 = last ? nB : cB + (size_t)(t + 2) * kstep;
            const char* a3 = a2 + kstep; const char* b3 = b2 + kstep;
            unsigned x0[2], x1[2];
#pragma unroll
            for (int i = 0; i < 2; ++i) { x0[i] = last ? n0[i] : c0[i]; x1[i] = last ? n1[i] : c1[i]; }
            PG8_LDB(B0, 0, 0); PG8_LDB(B1, 0, 1); PG8_SCHED; PG8_LDA(At, 0, 0); PG8_STAGE(PG8_SA(1, 1), a1, c1);
            PG8_WAIT_V(8); PG8_WAIT_L(0); PG8_BAR; PG8_MMA(0, 0, At, B0); PG8_MMA(0, 1, At, B1); PG8_BAR; PG8_SCHED;
            PG8_LDA(At, 0, 1); PG8_STAGE(PG8_SB(0, 0), b2, voffB); PG8_STAGE(PG8_SB(0, 1), b2 + hstep, voffB); PG8_STAGE(PG8_SA(0, 0), a2, x0);
            PG8_WAIT_V(8); PG8_WAIT_L(0); PG8_BAR; PG8_MMA(1, 0, At, B0); PG8_MMA(1, 1, At, B1); PG8_BAR; PG8_SCHED;
            PG8_LDB(B0, 1, 0); PG8_LDB(B1, 1, 1); PG8_SCHED; PG8_LDA(At, 1, 0); PG8_STAGE(PG8_SA(0, 1), a2, x1);
            PG8_WAIT_V(8); PG8_WAIT_L(0); PG8_BAR; PG8_MMA(0, 0, At, B0); PG8_MMA(0, 1, At, B1); PG8_BAR; PG8_SCHED;
            PG8_LDA(At, 1, 1); PG8_STAGE(PG8_SB(1, 0), b3, voffB); PG8_STAGE(PG8_SB(1, 1), b3 + hstep, voffB); PG8_STAGE(PG8_SA(1, 0), a3, x0);
            PG8_WAIT_V(8); PG8_WAIT_L(0); PG8_BAR; PG8_MMA(1, 0, At, B0); PG8_MMA(1, 1, At, B1); PG8_BAR; PG8_SCHED;
            if constexpr (Sched::DEFER) { if (t == 0 && pend) { S.done(pu, lane); pend = false; } }
        }
        if constexpr (Epi::FP8) asm volatile("s_nop 15\n\ts_nop 15" ::: "memory");
        if (wr == 0) PG8_BAR;
        E(acc, cur, wr, wc, fr, fq);
        if constexpr (Sched::DEFER) { pu = cur; pend = true; } else { S.done(cur, lane); }
        if (!has_next) break;
#pragma unroll
        for (int a = 0; a < 2; ++a)
#pragma unroll
            for (int b = 0; b < 2; ++b)
#pragma unroll
                for (int m = 0; m < 4; ++m)
#pragma unroll
                    for (int n = 0; n < 2; ++n) acc[a][b][m][n] = (f32x4){0.f, 0.f, 0.f, 0.f};
        cur = nxt; cB = nB; cA = nA; ++ui;
#pragma unroll
        for (int i = 0; i < 2; ++i) { c0[i] = n0[i]; c1[i] = n1[i]; }
        if (wr == 1) PG8_BAR;
    }
    PG8_WAIT_V(0);
    if constexpr (Sched::DEFER) { if (pend) S.done(pu, lane); }
    PG8_BAR;
#undef PG8_SA
#undef PG8_SB
#undef PG8_STAGE
#undef PG8_LDA
#undef PG8_LDB
#undef PG8_MMA
#undef PG8_WAIT_V
#undef PG8_WAIT_L
#undef PG8_BAR
#undef PG8_SCHED
#undef PG8_AOFFS
}
}

struct Args { const float* in[18]; float* out; unsigned char* ws; int ph_lo, ph_hi; };
typedef const float* const __attribute__((address_space(4)))* kin_t;
struct Frame {
    LAS unsigned char* lds;
    int tid, lane, wave, vcu, G, bid;
    unsigned char* ws; const Args* ap;
    __device__ __forceinline__ const float* in(int i) const { return ((kin_t)(uintptr_t)ap)[i]; }
    __device__ __forceinline__ float* out() const { return (float*)((kin_t)(uintptr_t)ap)[18]; }
    __device__ __forceinline__ unsigned* ctl() const { return (unsigned*)(ws + WS_CTL); }
    __device__ __forceinline__ float* MOD() const { return (float*)(ws + WS_MOD); }
    __device__ __forceinline__ float* ROPE() const { return (float*)(ws + WS_ROPE); }
    __device__ __forceinline__ float* AFF() const { return (float*)(ws + WS_AFF); }
    __device__ __forceinline__ float* GATE() const { return (float*)(ws + WS_GATE); }
    __device__ __forceinline__ float* X() const { return (float*)(ws + WS_X); }
    __device__ __forceinline__ float* X1() const { return (float*)(ws + WS_X1); }
    __device__ __forceinline__ float* U() const { return (float*)(ws + WS_U); }
    __device__ __forceinline__ int* ROWS() const { return (int*)(ws + WS_ROWS); }
    __device__ __forceinline__ short* INV() const { return (short*)(ws + WS_INV); }
    __device__ __forceinline__ bf16_t* H() const { return (bf16_t*)(ws + WS_H); }
    __device__ __forceinline__ bf16_t* PROJ() const { return (bf16_t*)(ws + WS_PROJ); }
    __device__ __forceinline__ bf16_t* MIX() const { return (bf16_t*)(ws + WS_MIX); }
    __device__ __forceinline__ bf16_t* ST() const { return (bf16_t*)(ws + WS_ST); }
    __device__ __forceinline__ bf16_t* ACT() const { return (bf16_t*)(ws + WS_ACT); }
    __device__ __forceinline__ bf16_t* YB() const { return (bf16_t*)(ws + WS_YB); }
    __device__ __forceinline__ bf16_t* WIN() const { return (bf16_t*)(ws + WS_WIN); }
    __device__ __forceinline__ bf16_t* WOUT() const { return (bf16_t*)(ws + WS_WOUT); }
    __device__ __forceinline__ bf16_t* WGU() const { return (bf16_t*)(ws + WS_WGU); }
    __device__ __forceinline__ bf16_t* WD() const { return (bf16_t*)(ws + WS_WD); }
};

constexpr int CW_C5 = 16384;
constexpr int CW_C8 = 65536;
__device__ __forceinline__ void wait_counter(unsigned* cnt, unsigned need, int tid) {
    if (tid < 64) {
        unsigned polls = 0;
        while ((unsigned)__builtin_amdgcn_readfirstlane(__hip_atomic_load(cnt, __ATOMIC_RELAXED, __HIP_MEMORY_SCOPE_AGENT)) < need) {
            __builtin_amdgcn_s_sleep(2);
            if (++polls > (1u << 22)) break;
        }
        __builtin_amdgcn_fence(__ATOMIC_ACQUIRE, "agent");
        asm volatile("s_waitcnt vmcnt(0)" ::: "memory");
    }
    asm volatile("" ::: "memory"); __builtin_amdgcn_s_barrier(); asm volatile("" ::: "memory");
}
__device__ __forceinline__ void arrive_counter(unsigned* cnt, int lane) {
    if (lane == 0) __hip_atomic_fetch_add(cnt, 1u, __ATOMIC_RELAXED, __HIP_MEMORY_SCOPE_AGENT);
}

struct SchedDense {
    static constexpr bool DEFER = false;
    int nM, nN, nwg, G, c; const char* A; const char* Bt; int K;
    __device__ __forceinline__ bool next(int i, pg8::Unit& u) const {
        const long L = (long)i * G + c; if (L >= nwg) return false;
        int wgid = (int)L; { const int q = nwg / 8, r = nwg % 8, xcd = wgid % 8, off = wgid / 8; wgid = (xcd < r ? xcd * (q + 1) : r * (q + 1) + (xcd - r) * q) + off; }
        const int nig = 8 * nN, gid = wgid / nig, fm = gid * 8, gsz = (nM - fm) < 8 ? (nM - fm) : 8;
        u.pm = fm + ((wgid % nig) % gsz); u.pn = (wgid % nig) / gsz; u.e = 0; u.t = 0; return true;
    }
    __device__ __forceinline__ int arow(const pg8::Unit& u, int r) const { return u.pm * 256 + r; }
    __device__ __forceinline__ const char* abase(const pg8::Unit&) const { return A; }
    __device__ __forceinline__ const char* bbase(const pg8::Unit& u) const { return Bt + (size_t)u.pn * 256 * K * 2; }
    __device__ __forceinline__ void a_ready(const pg8::Unit&, int) const {}
    __device__ __forceinline__ void done(const pg8::Unit&, int) const {}
};
struct SchedOut {
    static constexpr bool DEFER = false;
    int nwg, G, c; const char* A; const char* Bt; unsigned* cnt;
    __device__ __forceinline__ bool next(int i, pg8::Unit& u) const {
        const int L = i * G + c; if (L >= nwg) return false;
        if (L < 256) { const int wgid = (L % 8) * 32 + L / 8; u.pm = (wgid / 32) * 8 + (wgid % 32) % 8; u.pn = (wgid % 32) / 8; }
        else { const int j = L - 256; u.pm = 64 + j % 4; u.pn = j / 4; }
        u.e = 0; u.t = 0; return true;
    }
    __device__ __forceinline__ int arow(const pg8::Unit& u, int r) const { return u.pm * 256 + r; }
    __device__ __forceinline__ const char* abase(const pg8::Unit&) const { return A; }
    __device__ __forceinline__ const char* bbase(const pg8::Unit& u) const { return Bt + (size_t)u.pn * 256 * 1024 * 2; }
    __device__ __forceinline__ void a_ready(const pg8::Unit&, int) const {}
    __device__ __forceinline__ void done(const pg8::Unit& u, int lane) const { asm volatile("s_waitcnt vmcnt(0)" ::: "memory"); arrive_counter(cnt + 64 * u.pm, lane); }
};
struct SchedFfn {
    static constexpr bool DEFER = true;
    int nM, n8, n9, G, c; const char* Hb; const char* ACTb; const char* Wgu; const char* Wd; const LAS int* lrows; unsigned* cnt;
    __device__ __forceinline__ bool next(int i, pg8::Unit& u) const {
        const int L = i * G + c; if (L >= n8 + n9) return false;
        if (L < n8) { u.t = i << 8; const int wgid = (L % 8) * (n8 / 8) + L / 8; const int per = nM * 8; u.e = wgid / per; const int r = wgid % per; u.pn = r / nM; u.pm = r % nM; }
        else { u.t = 1 | (i << 8); const int j = L - n8, half = n9 / 2, eh = j / half, jj = j % half; const int wgid = (jj % 8) * (half / 8) + jj / 8; const int per = nM * 4;
               u.e = 2 * (wgid / per) + eh; const int r = wgid % per; u.pn = r / nM; u.pm = r % nM; }
        return true;
    }
    __device__ __forceinline__ int arow(const pg8::Unit& u, int r) const { return (u.t & 1) == 0 ? lrows[(u.t >> 8) * 256 + r] : u.e * EROWS + u.pm * 256 + r; }
    __device__ __forceinline__ const char* abase(const pg8::Unit& u) const { return (u.t & 1) == 0 ? Hb : ACTb; }
    __device__ __forceinline__ const char* bbase(const pg8::Unit& u) const {
        constexpr size_t ESZ = FFN_FP8 ? 1 : 2;
        return (u.t & 1) == 0 ? Wgu + (size_t)u.e * 2048 * 1024 * ESZ + (size_t)u.pn * 256 * 1024 * ESZ : Wd + (size_t)u.e * 1024 * 1024 * ESZ + (size_t)u.pn * 256 * 1024 * ESZ; }
    __device__ __forceinline__ void a_ready(const pg8::Unit& u, int tid) const { if (u.t & 1) wait_counter(cnt + 64 * (u.e * 9 + u.pm), 64u, tid); }
    __device__ __forceinline__ void done(const pg8::Unit& u, int lane) const { if ((u.t & 1) == 0) arrive_counter(cnt + 64 * (u.e * 9 + u.pm), lane); }
};

struct EpiIn {
    static constexpr bool PERM = true, FP8 = false;
    bf16_t* O; const LAS float* rope;
    __device__ __forceinline__ void operator()(const f32x4 (&acc)[2][2][4][2], const pg8::Unit& u, int wr, int wc, int fr, int fq) const {
        const bool latent = u.pm < 64;
        const bool lowhalf = fq < 2;
#pragma unroll
        for (int bj = 0; bj < 2; ++bj) {
            const int seg = 2 * u.pn + bj;
            const bool is_rope = latent && (seg == 6 || seg == 7 || seg == 8 || seg == 9 || (seg >= 16 && seg <= 20));
            const float sc = (seg == 8 || seg == 9 || (seg >= 16 && seg <= 19)) ? 0.125f : 1.0f;
            const int colb = u.pn * 256 + bj * 128 + wc * 32 + 8 * fq;
#pragma unroll
            for (int ai = 0; ai < 2; ++ai)
#pragma unroll
                for (int m = 0; m < 4; ++m) {
                    const int row = u.pm * 256 + ai * 128 + wr * 64 + m * 16 + fr;
                    f32x4 v0 = acc[ai][bj][m][0] * sc, v1 = acc[ai][bj][m][1] * sc;
                    if (is_rope) {
                        const int t = row & (SEQ - 1);
                        const int pos = (wc & 1) ? (t & 63) : (t >> 6);
                        const LAS float* cp = rope + pos * 16 + 8 * (fq & 1);
                        const f32x4 c0 = *(const LAS f32x4*)cp, c1 = *(const LAS f32x4*)(cp + 4);
                        f32x4 s0 = *(const LAS f32x4*)(cp + 1024), s1 = *(const LAS f32x4*)(cp + 1028);
                        if (lowhalf) { s0 = -s0; s1 = -s1; }
                        f32x4 o0, o1;
#pragma unroll
                        for (int i = 0; i < 4; ++i) {
                            { const auto rr = __builtin_amdgcn_permlane32_swap(__float_as_uint(v0[i]), __float_as_uint(v0[i]), false, false);
                              const float other = __uint_as_float(lowhalf ? rr[1] : rr[0]); o0[i] = v0[i] * c0[i] + other * s0[i]; }
                            { const auto rr = __builtin_amdgcn_permlane32_swap(__float_as_uint(v1[i]), __float_as_uint(v1[i]), false, false);
                              const float other = __uint_as_float(lowhalf ? rr[1] : rr[0]); o1[i] = v1[i] * c1[i] + other * s1[i]; }
                        }
                        v0 = o0; v1 = o1;
                    }
                    u32x4 w; w.x = pk2(v0[0], v0[1]); w.y = pk2(v0[2], v0[3]); w.z = pk2(v1[0], v1[1]); w.w = pk2(v1[2], v1[3]);
                    *(u32x4*)(O + (size_t)row * INW + colb) = w;
                }
        }
    }
};
struct EpiOut {
    static constexpr bool PERM = true, FP8 = false;
    bf16_t* Y1; const float* mod;
    __device__ __forceinline__ void operator()(const f32x4 (&acc)[2][2][4][2], const pg8::Unit& u, int wr, int wc, int fr, int fq) const {
        const int b = u.pm < 64 ? (u.pm >> 4) : 4;
        const float* g1 = mod + b * 6144 + 2048;
        const __amdgpu_buffer_rsrc_t rs = __builtin_amdgcn_make_buffer_rsrc((void*)Y1, (short)0, MROWS * D * 2, 0x00020000);
#pragma unroll
        for (int bj = 0; bj < 2; ++bj) {
            const int col = u.pn * 256 + bj * 128 + wc * 32 + 8 * fq;
            const f32x4 g0 = *(const f32x4*)(g1 + col), g1v = *(const f32x4*)(g1 + col + 4);
#pragma unroll
            for (int ai = 0; ai < 2; ++ai)
#pragma unroll
                for (int m = 0; m < 4; ++m) {
                    const int row = u.pm * 256 + ai * 128 + wr * 64 + m * 16 + fr;
                    const f32x4 r0 = g0 * acc[ai][bj][m][0], r1 = g1v * acc[ai][bj][m][1];
                    u32x4 w; w.x = pk2(r0[0], r0[1]); w.y = pk2(r0[2], r0[3]); w.z = pk2(r1[0], r1[1]); w.w = pk2(r1[2], r1[3]);
                    __builtin_amdgcn_raw_buffer_store_b128(w, rs, (unsigned)((row * D + col) * 2), 0, 16);
                }
        }
    }
};
__device__ __forceinline__ unsigned pk4_fp8(float a, float b, float c, float d) { unsigned w = 0u; w = __builtin_amdgcn_cvt_pk_fp8_f32(a, b, w, false); w = __builtin_amdgcn_cvt_pk_fp8_f32(c, d, w, true); return w; }
struct EpiFfn {
    static constexpr bool PERM = true, FP8 = (FFN_FP8 != 0);
    void* ACT; bf16_t* YB; const float* gate;
    __device__ __forceinline__ void operator()(const f32x4 (&acc)[2][2][4][2], const pg8::Unit& u, int wr, int wc, int fr, int fq) const {
        if ((u.t & 1) == 0) {
            constexpr float ASC = FP8 ? (1.0f / 32.0f) : 1.0f;
            constexpr float OSC = FP8 ? 8.0f : 1.0f;
            const __amdgpu_buffer_rsrc_t rs = __builtin_amdgcn_make_buffer_rsrc(ACT, (short)0, NE * EROWS * 1024 * (FP8 ? 1 : 2), 0x00020000);
#pragma unroll
            for (int ai = 0; ai < 2; ++ai)
#pragma unroll
                for (int m = 0; m < 4; ++m) {
                    const int row = u.e * EROWS + u.pm * 256 + ai * 128 + wr * 64 + m * 16 + fr;
                    float r[8];
#pragma unroll
                    for (int n = 0; n < 2; ++n)
#pragma unroll
                        for (int q = 0; q < 4; ++q) { const float a = acc[ai][0][m][n][q] * ASC; r[4 * n + q] = a * __builtin_amdgcn_rcpf(1.0f + fexp(-a)) * (acc[ai][1][m][n][q] * (ASC * OSC)); }
                    if constexpr (FP8) {
                        const unsigned long long w = (unsigned long long)pk4_fp8(r[0], r[1], r[2], r[3]) | ((unsigned long long)pk4_fp8(r[4], r[5], r[6], r[7]) << 32);
                        __hip_atomic_store((unsigned long long*)((unsigned char*)ACT + (size_t)row * 1024 + u.pn * 128 + wc * 32 + 8 * fq), w, __ATOMIC_RELAXED, __HIP_MEMORY_SCOPE_AGENT);
                    } else {
                        u32x4 w; w.x = pk2(r[0], r[1]); w.y = pk2(r[2], r[3]); w.z = pk2(r[4], r[5]); w.w = pk2(r[6], r[7]);
                        __builtin_amdgcn_raw_buffer_store_b128(w, rs, (unsigned)((row * 1024 + u.pn * 128 + wc * 32 + 8 * fq) * 2), 0, 16);
                    }
                }
        } else {
            constexpr float YSC = FP8 ? (64.0f / 256.0f) : 1.0f;
#pragma unroll
            for (int ai = 0; ai < 2; ++ai)
#pragma unroll
                for (int m = 0; m < 4; ++m) {
                    const int row = u.e * EROWS + u.pm * 256 + ai * 128 + wr * 64 + m * 16 + fr;
                    const float gt = gate[row] * YSC;
#pragma unroll
                    for (int bj = 0; bj < 2; ++bj) {
                        const f32x4 r0 = acc[ai][bj][m][0] * gt, r1 = acc[ai][bj][m][1] * gt;
                        if constexpr (FP8) {
                            u32x2 w; w.x = pk4_fp8(r0[0], r0[1], r0[2], r0[3]); w.y = pk4_fp8(r1[0], r1[1], r1[2], r1[3]);
                            *(u32x2*)((unsigned char*)YB + (size_t)row * 1024 + u.pn * 256 + bj * 128 + wc * 32 + 8 * fq) = w;
                        } else {
                            u32x4 w; w.x = pk2(r0[0], r0[1]); w.y = pk2(r0[2], r0[3]); w.z = pk2(r1[0], r1[1]); w.w = pk2(r1[2], r1[3]);
                            *(u32x4*)(YB + (size_t)row * 1024 + u.pn * 256 + bj * 128 + wc * 32 + 8 * fq) = w;
                        }
                    }
                }
        }
    }
};

__device__ __forceinline__ void p0_transpose_item(const float* W, int N, bf16_t* WT, int out_row0, LAS unsigned* scr, int kb, int n0, int lane) {
    const int k0 = 64 * kb;
    const float* wp = W + (size_t)k0 * N + n0 + lane;
#pragma unroll
    for (int g = 0; g < 2; ++g) {
        float t[32];
#pragma unroll
        for (int i = 0; i < 32; ++i) t[i] = __builtin_nontemporal_load(wp + (size_t)(32 * g + i) * N);
#pragma unroll
        for (int i = 0; i < 16; ++i) scr[(16 * g + i) * 65 + lane] = pk2(t[2 * i], t[2 * i + 1]);
    }
    LDS_WAIT(); asm volatile("" ::: "memory");
    const int c = lane & 7;
#pragma unroll
    for (int j = 0; j < 8; ++j) { const int n = (lane >> 3) + 8 * j; const LAS unsigned* sp = scr + (4 * c) * 65 + n;
        u32x4 o; o.x = sp[0]; o.y = sp[65]; o.z = sp[130]; o.w = sp[195];
        __builtin_nontemporal_store(o, (u32x4*)(WT + (size_t)(out_row0 + n) * 1024 + k0 + 8 * c)); }
    LDS_WAIT(); asm volatile("" ::: "memory");
}
#if FFN_FP8
__device__ __forceinline__ void p0_transpose_item8(const float* W, int N, unsigned char* WT, int out_row0, LAS unsigned* scr, int kb, int n0, int lane) {
    const int k0 = 64 * kb;
    const float* wp = W + (size_t)k0 * N + n0 + lane;
#pragma unroll
    for (int g = 0; g < 2; ++g) {
        float t[32];
#pragma unroll
        for (int i = 0; i < 32; ++i) t[i] = __builtin_nontemporal_load(wp + (size_t)(32 * g + i) * N) * 32.0f;
#pragma unroll
        for (int i = 0; i < 8; ++i) scr[(8 * g + i) * 65 + lane] = pk4_fp8(t[4 * i], t[4 * i + 1], t[4 * i + 2], t[4 * i + 3]);
    }
    LDS_WAIT(); asm volatile("" ::: "memory");
    const int c = lane & 3;
#pragma unroll
    for (int j = 0; j < 4; ++j) { const int n = (lane >> 2) + 16 * j; const LAS unsigned* sp = scr + (4 * c) * 65 + n;
        u32x4 o; o.x = sp[0]; o.y = sp[65]; o.z = sp[130]; o.w = sp[195];
        __builtin_nontemporal_store(o, (u32x4*)(WT + (size_t)(out_row0 + n) * 1024 + k0 + 16 * c)); }
    LDS_WAIT(); asm volatile("" ::: "memory");
}
#endif
constexpr int CV_IN = 16 * (INW / 64), CV_SQ = 16 * 16, CV_LAYER = CV_IN + CV_SQ + NE * 3 * CV_SQ;
__device__ __forceinline__ void convert_item(Frame& F, int l, int it, LAS unsigned* scr) {
    int r = it;
    if (r < CV_IN) { const int kb = r / (INW / 64), nb = r % (INW / 64);
        p0_transpose_item(F.in(8) + (size_t)l * 1024 * INW, INW, F.WIN() + (size_t)l * INW * 1024, 64 * nb, scr, kb, 64 * nb, F.lane); return; }
    r -= CV_IN;
    if (r < CV_SQ) { const int kb = r / 16, nb = r % 16;
        p0_transpose_item(F.in(12) + (size_t)l * 1024 * 1024, 1024, F.WOUT() + (size_t)l * 1024 * 1024, 64 * nb, scr, kb, 64 * nb, F.lane); return; }
    r -= CV_SQ;
    const int mat = r / CV_SQ; r %= CV_SQ; const int kb = r / 16, nb = r % 16; const int which = mat % 3, le = l * NE + mat / 3;
#if FFN_FP8
    unsigned char* wgu8 = (unsigned char*)F.WGU() + (size_t)le * 2048 * 1024; unsigned char* wd8 = (unsigned char*)F.WD() + (size_t)le * 1024 * 1024;
    if (which == 0) p0_transpose_item8(F.in(14) + (size_t)le * 1024 * 1024, 1024, wgu8, (nb >> 1) * 256 + (nb & 1) * 64, scr, kb, 64 * nb, F.lane);
    else if (which == 1) p0_transpose_item8(F.in(15) + (size_t)le * 1024 * 1024, 1024, wgu8, (nb >> 1) * 256 + 128 + (nb & 1) * 64, scr, kb, 64 * nb, F.lane);
    else p0_transpose_item8(F.in(16) + (size_t)le * 1024 * 1024, 1024, wd8, 64 * nb, scr, kb, 64 * nb, F.lane);
#else
    if (which == 0) p0_transpose_item(F.in(14) + (size_t)le * 1024 * 1024, 1024, F.WGU() + (size_t)le * 2048 * 1024, (nb >> 1) * 256 + (nb & 1) * 64, scr, kb, 64 * nb, F.lane);
    else if (which == 1) p0_transpose_item(F.in(15) + (size_t)le * 1024 * 1024, 1024, F.WGU() + (size_t)le * 2048 * 1024, (nb >> 1) * 256 + 128 + (nb & 1) * 64, scr, kb, 64 * nb, F.lane);
    else p0_transpose_item(F.in(16) + (size_t)le * 1024 * 1024, 1024, F.WD() + (size_t)le * 1024 * 1024, 64 * nb, scr, kb, 64 * nb, F.lane);
#endif
}
__device__ __forceinline__ void p0_prologue(Frame& F) {
    LAS unsigned* scr = (LAS unsigned*)(F.lds + F.wave * 16384);
    const int gw = F.vcu * NWAVES + F.wave, NGW = F.G * NWAVES;
    for (int it = gw; it < DEPTH * CV_LAYER; it += NGW) convert_item(F, it / CV_LAYER, it % CV_LAYER, scr);
    __syncthreads();
    LAS float* sS = (LAS float*)F.lds;
    LAS float* red = (LAS float*)(F.lds + 32768);
    for (int i = F.tid; i < 5 * 1024; i += NTHREADS) { const float v = i < 4096 ? F.in(1)[i] : F.in(3)[i - 4096]; sS[i] = silu_f(v); }
    __syncthreads();
    for (int item = F.bid; item < DEPTH * 96; item += F.G) {
        const int l = item / 96, jg = item % 96, j = jg * 64 + F.lane;
        const float* wp = F.in(4) + ((size_t)l * 1024 + F.wave * 128) * 6144 + j;
        float a0 = 0.f, a1 = 0.f, a2 = 0.f, a3 = 0.f, a4 = 0.f;
#pragma unroll 8
        for (int kk = 0; kk < 128; ++kk) { const float w = __builtin_nontemporal_load(wp + (size_t)kk * 6144); const int k = F.wave * 128 + kk;
            a0 += sS[k] * w; a1 += sS[1024 + k] * w; a2 += sS[2048 + k] * w; a3 += sS[3072 + k] * w; a4 += sS[4096 + k] * w; }
        red[(F.wave * 5 + 0) * 64 + F.lane] = a0; red[(F.wave * 5 + 1) * 64 + F.lane] = a1; red[(F.wave * 5 + 2) * 64 + F.lane] = a2;
        red[(F.wave * 5 + 3) * 64 + F.lane] = a3; red[(F.wave * 5 + 4) * 64 + F.lane] = a4;
        __syncthreads();
        if (F.tid < 320) { const int b = F.tid >> 6, ln = F.tid & 63; float s = F.in(5)[l * 6144 + jg * 64 + ln];
#pragma unroll
            for (int w = 0; w < 8; ++w) s += red[(w * 5 + b) * 64 + ln];
            F.MOD()[(size_t)(l * 5 + b) * 6144 + jg * 64 + ln] = s; }
        __syncthreads();
    }
    if (F.bid == F.G - 1) {
        for (int i = F.tid; i < 1024; i += NTHREADS) {
            const int pos = i >> 4, f = i & 15;
            const float invf = exp2f(-(float)f * (13.287712379549449f / 16.0f));
            const float angf = (float)pos * invf;
            double a = (double)angf; const double TWO_PI = 6.283185307179586476925;
            a -= TWO_PI * rint(a / TWO_PI);
            const double a2 = a * a; double cs = 1.0, sn = a, tc = 1.0, ts = a;
#pragma unroll 1
            for (int n = 1; n <= 12; ++n) { tc *= -a2 / (double)((2 * n - 1) * (2 * n)); ts *= -a2 / (double)((2 * n) * (2 * n + 1)); cs += tc; sn += ts; }
            F.ROPE()[i] = (float)cs; F.ROPE()[1024 + i] = (float)sn;
        }
    }
}

__device__ __forceinline__ f32x4 y1_quarter(const bf16_t* y1row, int lane, int j) { const u32x2 q = *(const u32x2*)(y1row + 4 * lane + 256 * j); return (f32x4){bflo(q.x), bfhi(q.x), bflo(q.y), bfhi(q.y)}; }
__device__ __forceinline__ const float* xsrc_row(const Frame& F, bool from_inputs, int row) {
    return from_inputs ? (row < NLAT ? F.in(0) + (size_t)row * D : F.in(2) + (size_t)(row - NLAT) * D) : F.X() + (size_t)row * D; }
__device__ __forceinline__ bf16_t* Y1buf(const Frame& F) { return (bf16_t*)(F.ws + WS_X1); }
__device__ __forceinline__ bf16_t* XBbuf(const Frame& F) { return (bf16_t*)(F.ws + WS_X); }
template <bool XIN> __device__ __forceinline__ const char* xrow_ptr(const Frame& F, int row) {
    if constexpr (XIN) return (const char*)xsrc_row(F, true, row); else return (const char*)(XBbuf(F) + (size_t)row * D); }
template <bool XIN> __device__ __forceinline__ f32x4 xrow_q(const char* p, int lane, int j) {
    if constexpr (XIN) return ((const f32x4*)p)[lane + 64 * j]; else return y1_quarter((const bf16_t*)p, lane, j); }
__device__ __forceinline__ void p1_one(Frame& F, int l, bool fin, int row, f32x4 (&v)[4], const u32x4 i0, const u32x4 i1, const f32x4 (&gm)[4], const f32x4 (&sh)[4], const f32x4 (&g2)[4]) {
    const int lane = F.lane;
    if (l > 0) {
        f32x4 ys[4];
#pragma unroll
        for (int j = 0; j < 4; ++j) ys[j] = (f32x4){0.f, 0.f, 0.f, 0.f};
#pragma unroll
        for (int e = 0; e < 16; ++e) {
            const unsigned w = (e < 8) ? i0[(e & 7) >> 1] : i1[(e & 7) >> 1];
            const int p = __builtin_amdgcn_readfirstlane((int)(short)((e & 1) ? (w >> 16) : (w & 0xffffu)));
            if (p >= 0) {
#if FFN_FP8
                const unsigned char* yr = (const unsigned char*)F.YB() + (size_t)(e * EROWS + p) * 1024;
#pragma unroll
                for (int j = 0; j < 4; ++j) { const unsigned q = __builtin_nontemporal_load((const unsigned*)(yr + 4 * lane + 256 * j));
                    ys[j][0] += __builtin_amdgcn_cvt_f32_fp8(q, 0); ys[j][1] += __builtin_amdgcn_cvt_f32_fp8(q, 1); ys[j][2] += __builtin_amdgcn_cvt_f32_fp8(q, 2); ys[j][3] += __builtin_amdgcn_cvt_f32_fp8(q, 3); }
#else
                const bf16_t* yr = F.YB() + (size_t)(e * EROWS + p) * 1024;
#pragma unroll
                for (int j = 0; j < 4; ++j) { const u32x2 q = *(const u32x2*)(yr + 4 * lane + 256 * j);
                    ys[j][0] += bflo(q.x); ys[j][1] += bfhi(q.x); ys[j][2] += bflo(q.y); ys[j][3] += bfhi(q.y); }
#endif
            }
        }
#pragma unroll
        for (int j = 0; j < 4; ++j) v[j] = v[j] + g2[j] * ys[j] * (FFN_FP8 ? (1.0f / 64.0f) : 1.0f);
    }
    if (!fin) {
#pragma unroll
        for (int j = 0; j < 4; ++j) { u32x2 w; w.x = pk2(v[j][0], v[j][1]); w.y = pk2(v[j][2], v[j][3]); *(u32x2*)(XBbuf(F) + (size_t)row * D + 4 * lane + 256 * j) = w; }
    }
    float ss = 0.f;
#pragma unroll
    for (int j = 0; j < 4; ++j) ss += (v[j][0] * v[j][0] + v[j][1] * v[j][1]) + (v[j][2] * v[j][2] + v[j][3] * v[j][3]);
    const float rstd = 1.0f / sqrtf(wave_sum(ss, lane) * (1.0f / D) + EPS);
    if (fin) {
#pragma unroll
        for (int j = 0; j < 4; ++j) __builtin_nontemporal_store(v[j] * rstd * gm[j], (f32x4*)(F.out() + (size_t)row * D) + lane + 64 * j);
    } else {
#pragma unroll
        for (int j = 0; j < 4; ++j) {
            const f32x4 h = v[j] * rstd * gm[j] + sh[j];
            u32x2 w; w.x = pk2(h[0], h[1]); w.y = pk2(h[2], h[3]);
            *(u32x2*)(F.H() + (size_t)row * D + 4 * lane + 256 * j) = w;
        }
    }
}
__device__ __forceinline__ void p1_mod(Frame& F, int l, bool fin, int b, f32x4 (&gm)[4], f32x4 (&sh)[4], f32x4 (&g2)[4]) {
    const int lane = F.lane;
#pragma unroll
    for (int j = 0; j < 4; ++j) {
        if (fin) { gm[j] = ((const f32x4*)F.in(17))[lane + 64 * j]; sh[j] = (f32x4){0.f, 0.f, 0.f, 0.f}; }
        else { const float* md = F.MOD() + (size_t)(l * 5 + b) * 6144;
            const f32x4 g = ((const f32x4*)(F.in(6) + l * D))[lane + 64 * j], sc = ((const f32x4*)(md + 1024))[lane + 64 * j];
            gm[j] = g * (sc + 1.0f); sh[j] = ((const f32x4*)md)[lane + 64 * j]; }
        if (l > 0) g2[j] = ((const f32x4*)(F.MOD() + (size_t)((l - 1) * 5 + b) * 6144 + 5 * 1024))[lane + 64 * j];
        else g2[j] = (f32x4){0.f, 0.f, 0.f, 0.f};
    }
}
template <bool XIN>
__device__ __forceinline__ void p1_rows(Frame& F, int l) {
    const bool fin = (l == DEPTH);
    const int lane = F.lane;
    const int gw = F.vcu * NWAVES + F.wave;
    f32x4 gm[4], sh[4], g2[4];
    {
        const int r0 = gw * 8, b = r0 >> 12;
        p1_mod(F, l, fin, b, gm, sh, g2);
        f32x4 v[4], vn[4], yn[4]; u32x4 i0 = (u32x4){0u, 0u, 0u, 0u}, i1 = i0, i0n = i0, i1n = i0;
#pragma unroll
        for (int j = 0; j < 4; ++j) { v[j] = xrow_q<XIN>(xrow_ptr<XIN>(F, r0), lane, j); if (l > 0) v[j] = v[j] + y1_quarter(Y1buf(F) + (size_t)r0 * D, lane, j); }
        if (l > 0) { i0 = *(const u32x4*)(F.INV() + (size_t)r0 * 16); i1 = *(const u32x4*)(F.INV() + (size_t)r0 * 16 + 8); }
#pragma unroll 1
        for (int i = 0; i < 8; ++i) {
            const int row = r0 + i;
            if (i < 7) {
#pragma unroll
                for (int j = 0; j < 4; ++j) { vn[j] = xrow_q<XIN>(xrow_ptr<XIN>(F, row + 1), lane, j); yn[j] = (l > 0) ? y1_quarter(Y1buf(F) + (size_t)(row + 1) * D, lane, j) : (f32x4){0.f, 0.f, 0.f, 0.f}; }
                if (l > 0) { i0n = *(const u32x4*)(F.INV() + (size_t)(row + 1) * 16); i1n = *(const u32x4*)(F.INV() + (size_t)(row + 1) * 16 + 8); }
            }
            p1_one(F, l, fin, row, v, i0, i1, gm, sh, g2);
#pragma unroll
            for (int j = 0; j < 4; ++j) v[j] = vn[j] + yn[j];
            i0 = i0n; i1 = i1n;
        }
    }
    if (!fin && (F.wave & 1) == 0) {
        const int row = NLAT + F.vcu * 4 + (F.wave >> 1);
        p1_mod(F, l, fin, 4, gm, sh, g2);
        f32x4 v[4]; u32x4 i0 = (u32x4){0u, 0u, 0u, 0u}, i1 = i0;
#pragma unroll
        for (int j = 0; j < 4; ++j) { v[j] = xrow_q<XIN>(xrow_ptr<XIN>(F, row), lane, j); if (l > 0) v[j] = v[j] + y1_quarter(Y1buf(F) + (size_t)row * D, lane, j); }
        if (l > 0) { i0 = *(const u32x4*)(F.INV() + (size_t)row * 16); i1 = *(const u32x4*)(F.INV() + (size_t)row * 16 + 8); }
        p1_one(F, l, fin, row, v, i0, i1, gm, sh, g2);
    }
}

template <int NR, bool XIN>
__device__ __forceinline__ void p6_group(Frame& F, int l, int row0, int b, LAS float* wl) {
    const int lane = F.lane;
    const char* xr = xrow_ptr<XIN>(F, row0);
    constexpr size_t XRB = XIN ? (size_t)D * 4 : (size_t)D * 2;
    const bf16_t* yr = Y1buf(F) + (size_t)row0 * D;
    float rstd[NR];
    {
        f32x4 v[NR][4];
#pragma unroll
        for (int r = 0; r < NR; ++r)
#pragma unroll
            for (int j = 0; j < 4; ++j) v[r][j] = xrow_q<XIN>(xr + (size_t)r * XRB, lane, j) + y1_quarter(yr + (size_t)r * D, lane, j);
#pragma unroll
        for (int r = 0; r < NR; ++r) {
            float ss = 0.f;
#pragma unroll
            for (int j = 0; j < 4; ++j) ss += (v[r][j][0] * v[r][j][0] + v[r][j][1] * v[r][j][1]) + (v[r][j][2] * v[r][j][2] + v[r][j][3] * v[r][j][3]);
            rstd[r] = 1.0f / sqrtf(wave_sum(ss, lane) * (1.0f / D) + EPS);
        }
    }
    float acc[NR][16];
#pragma unroll
    for (int r = 0; r < NR; ++r)
#pragma unroll
        for (int e = 0; e < 16; ++e) acc[r][e] = 0.f;
    const float* md = F.MOD() + (size_t)(l * 5 + b) * 6144;
    const float* g2w = F.in(7) + l * D;
    f32x4 cg, csc, csh, cx[NR]; u32x2 cy[NR];
#define P6_LOADQ(j_, g_, sc_, sh_, x_, y_) do { g_ = ((const f32x4*)g2w)[lane + 64 * (j_)]; sc_ = ((const f32x4*)(md + 4096))[lane + 64 * (j_)]; sh_ = ((const f32x4*)(md + 3072))[lane + 64 * (j_)]; \
        _Pragma("unroll") for (int r_ = 0; r_ < NR; ++r_) { x_[r_] = xrow_q<XIN>(xr + (size_t)r_ * XRB, lane, (j_)); y_[r_] = *(const u32x2*)(yr + (size_t)r_ * D + 4 * lane + 256 * (j_)); } } while (0)
    P6_LOADQ(0, cg, csc, csh, cx, cy);
#pragma unroll 1
    for (int j = 0; j < 4; ++j) {
        f32x4 ng = cg, nsc = csc, nsh = csh, nx[NR]; u32x2 ny[NR];
#pragma unroll
        for (int r = 0; r < NR; ++r) { nx[r] = cx[r]; ny[r] = cy[r]; }
        if (j < 3) P6_LOADQ(j + 1, ng, nsc, nsh, nx, ny);
        const f32x4 gmv = cg * (csc + 1.0f), shv = csh;
        f32x4 h[NR];
#pragma unroll
        for (int r = 0; r < NR; ++r) {
            const f32x4 vq = cx[r] + (f32x4){bflo(cy[r].x), bfhi(cy[r].x), bflo(cy[r].y), bfhi(cy[r].y)};
            h[r] = vq * rstd[r] * gmv + shv;
#if FFN_FP8
            *(unsigned*)((unsigned char*)F.H() + (size_t)(row0 + r) * D + 4 * lane + 256 * j) = pk4_fp8(h[r][0], h[r][1], h[r][2], h[r][3]);
#else
            u32x2 w; w.x = pk2(h[r][0], h[r][1]); w.y = pk2(h[r][2], h[r][3]);
            *(u32x2*)(F.H() + (size_t)(row0 + r) * D + 4 * lane + 256 * j) = w;
#endif
        }
#pragma unroll
        for (int i = 0; i < 4; ++i) {
            const LAS f32x4* wp = (const LAS f32x4*)(wl + ((j * 4 + i) * 64 + lane) * 16);
            const f32x4 w0 = wp[0], w1 = wp[1], w2 = wp[2], w3 = wp[3];
#pragma unroll
            for (int r = 0; r < NR; ++r) { const float hv = h[r][i];
                acc[r][0] += hv * w0[0]; acc[r][1] += hv * w0[1]; acc[r][2] += hv * w0[2]; acc[r][3] += hv * w0[3];
                acc[r][4] += hv * w1[0]; acc[r][5] += hv * w1[1]; acc[r][6] += hv * w1[2]; acc[r][7] += hv * w1[3];
                acc[r][8] += hv * w2[0]; acc[r][9] += hv * w2[1]; acc[r][10] += hv * w2[2]; acc[r][11] += hv * w2[3];
                acc[r][12] += hv * w3[0]; acc[r][13] += hv * w3[1]; acc[r][14] += hv * w3[2]; acc[r][15] += hv * w3[3]; }
        }
        cg = ng; csc = nsc; csh = nsh;
#pragma unroll
        for (int r = 0; r < NR; ++r) { cx[r] = nx[r]; cy[r] = ny[r]; }
    }
#undef P6_LOADQ
    const int e = ((lane >> 5) & 1) * 8 + ((lane >> 4) & 1) * 4 + ((lane >> 3) & 1) * 2 + ((lane >> 2) & 1);
#pragma unroll
    for (int r = 0; r < NR; ++r) {
        float r8[8], r4[4], r2[2], r1;
        { const bool hi = (lane & 32) != 0;
#pragma unroll
          for (int i = 0; i < 8; ++i) { const float keep = hi ? acc[r][i + 8] : acc[r][i], send = hi ? acc[r][i] : acc[r][i + 8]; r8[i] = keep + shx(send, 32, lane); } }
        { const bool hi = (lane & 16) != 0;
#pragma unroll
          for (int i = 0; i < 4; ++i) { const float keep = hi ? r8[i + 4] : r8[i], send = hi ? r8[i] : r8[i + 4]; r4[i] = keep + shx(send, 16, lane); } }
        { const bool hi = (lane & 8) != 0;
#pragma unroll
          for (int i = 0; i < 2; ++i) { const float keep = hi ? r4[i + 2] : r4[i], send = hi ? r4[i] : r4[i + 2]; r2[i] = keep + shx(send, 8, lane); } }
        { const bool hi = (lane & 4) != 0; const float keep = hi ? r2[1] : r2[0], send = hi ? r2[0] : r2[1]; r1 = keep + shx(send, 4, lane); }
        r1 += shx(r1, 2, lane); r1 += shx(r1, 1, lane);
        float mx = r1;
        mx = fmaxf(mx, shx(mx, 4, lane)); mx = fmaxf(mx, shx(mx, 8, lane)); mx = max_x16(mx); mx = max_x32(mx);
        const float ex = __expf(r1 - mx);
        float sm = ex;
        sm += shx(sm, 4, lane); sm += shx(sm, 8, lane); sm = sum_x16(sm); sm = sum_x32(sm);
        const float aff = ex / sm;
        const int row = row0 + r;
        if ((lane & 3) == 0) {
            if (row < NLAT) F.AFF()[(size_t)(b * NE + e) * SEQ + (row & (SEQ - 1))] = aff;
            else { const int rc = row - NLAT; F.AFF()[(size_t)BATCH * NE * SEQ + (size_t)((rc >> 8) * NE + e) * CTXL + (rc & 255)] = aff; }
        }
    }
}
template <bool XIN>
__device__ __forceinline__ void p6_rows(Frame& F0, int l, unsigned* cnt5) {
    Frame F = F0; asm volatile("" : "+v"(F.lane), "+v"(F.tid), "+s"(F.vcu), "+s"(F.wave));
    LAS float* wl = (LAS float*)F.lds;
    {
        const f32x4* wsrc = (const f32x4*)(F.in(13) + (size_t)l * 1024 * 16);
        f32x4 t[8];
#pragma unroll
        for (int i = 0; i < 8; ++i) t[i] = wsrc[F.tid + NTHREADS * i];
#pragma unroll
        for (int i = 0; i < 8; ++i) { const int c = F.tid + NTHREADS * i, k = c >> 2, e0 = (c & 3) * 4;
            *(LAS f32x4*)(wl + (((k >> 8) * 4 + (k & 3)) * 64 + ((k >> 2) & 63)) * 16 + e0) = t[i]; }
    }
    __syncthreads();
    const int gw = F.vcu * NWAVES + F.wave;
    {
        const int r0 = gw * 8, b = r0 >> 12;
        wait_counter(cnt5 + 64 * (F.vcu >> 2), 32u, F.tid);
#pragma unroll 1
        for (int gi = 0; gi < 2; ++gi) p6_group<4, XIN>(F, l, r0 + 4 * gi, b, wl);
    }
    if (l != DEPTH - 1) {
        wait_counter(cnt5 + 64 * (64 + (F.vcu >> 2)), 32u, F.tid);
        if ((F.wave & 1) == 0) p6_group<1, XIN>(F, l, NLAT + F.vcu * 4 + (F.wave >> 1), 4, wl);
    }
}

__device__ __forceinline__ void p5_ctx_piece(Frame& F, int l, unsigned* cnt5) {
    const int lane = F.lane, fr = lane & 15, fq = lane >> 4;
    const int g = F.vcu >> 2, cq = F.vcu & 3;
    const int row0 = NLAT + 16 * g;
    const int n0 = 256 * cq + 32 * F.wave;
    const bf16_t* ap = F.MIX() + (size_t)(row0 + fr) * D + 8 * fq;
    const bf16_t* bp = F.WOUT() + (size_t)l * 1024 * 1024 + (size_t)(n0 + fr) * 1024 + 8 * fq;
    f32x4 acc0 = (f32x4){0.f, 0.f, 0.f, 0.f}, acc1 = acc0;
#pragma unroll 1
    for (int s0 = 0; s0 < 32; s0 += 8) {
        bf16x8 a[8], b0[8], b1[8];
#pragma unroll
        for (int k = 0; k < 8; ++k) { a[k] = *(const bf16x8*)(ap + 32 * (s0 + k)); b0[k] = *(const bf16x8*)(bp + 32 * (s0 + k)); b1[k] = *(const bf16x8*)(bp + 16 * 1024 + 32 * (s0 + k)); }
#pragma unroll
        for (int k = 0; k < 8; ++k) { acc0 = __builtin_amdgcn_mfma_f32_16x16x32_bf16(a[k], b0[k], acc0, 0, 0, 0); acc1 = __builtin_amdgcn_mfma_f32_16x16x32_bf16(a[k], b1[k], acc1, 0, 0, 0); }
    }
    const float* g1 = F.MOD() + (size_t)(l * 5 + 4) * 6144 + 2048;
    bf16_t* yo = Y1buf(F) + (size_t)row0 * D;
#pragma unroll
    for (int t = 0; t < 2; ++t) {
        const int col = n0 + 16 * t + fr; const float gg = g1[col];
#pragma unroll
        for (int r = 0; r < 4; ++r) { const int rr = 4 * fq + r; const float v = gg * (t == 0 ? acc0[r] : acc1[r]);
            __hip_atomic_store(yo + (size_t)rr * D + col, (bf16_t)(pk2(v, 0.f) & 0xffffu), __ATOMIC_RELAXED, __HIP_MEMORY_SCOPE_AGENT); }
    }
    asm volatile("s_waitcnt vmcnt(0)" ::: "memory");
    arrive_counter(cnt5 + 64 * (64 + g), lane);
}

__device__ __forceinline__ int wave_isum(int v, int lane) {
    v += shxi(v, 1, lane); v += shxi(v, 2, lane); v += shxi(v, 4, lane); v += shxi(v, 8, lane); v += shxi(v, 16, lane); v += shxi(v, 32, lane);
    return v;
}
__device__ __forceinline__ void p7_topk(Frame& F, int l) {
    LAS int* cnts = (LAS int*)F.lds;
    const int nprob = (l == DEPTH - 1) ? 64 : 128;
    const int tid = F.tid, lane = F.lane, wave = F.wave;
    for (int prob = F.bid; prob < nprob; prob += F.G) {
        const bool isc = prob >= 64; const int pb = prob & 63; const int b = pb >> 4, e = pb & 15;
        const int n = isc ? CTXL : SEQ, KSEL = isc ? CAP_C : CAP_L;
        const float* aff = isc ? F.AFF() + (size_t)BATCH * NE * SEQ + (size_t)(b * NE + e) * CTXL : F.AFF() + (size_t)(b * NE + e) * SEQ;
        unsigned key[8];
        if (tid * 8 < n) { const u32x4 k0 = *(const u32x4*)(aff + tid * 8), k1 = *(const u32x4*)(aff + tid * 8 + 4);
            key[0] = k0.x; key[1] = k0.y; key[2] = k0.z; key[3] = k0.w; key[4] = k1.x; key[5] = k1.y; key[6] = k1.z; key[7] = k1.w; }
        else {
#pragma unroll
            for (int i = 0; i < 8; ++i) key[i] = 0u;
        }
        unsigned prefix = 0u; int krem = KSEL;
        LAS int* hist = (LAS int*)(F.lds + 1024);
        LAS int* wtot = (LAS int*)(F.lds + 512);
#pragma unroll 1
        for (int pass = 0; pass < 3; ++pass) {
            const int shift = pass == 0 ? 19 : (pass == 1 ? 7 : 0), nbits = pass == 2 ? 7 : 12, hshift = shift + nbits;
            const int nb = 1 << nbits;
#pragma unroll
            for (int i = 0; i < 8; ++i) hist[tid * 8 + i] = 0;
            __syncthreads();
#pragma unroll
            for (int i = 0; i < 8; ++i) { const unsigned k = key[i]; if (k != 0u && (k >> hshift) == prefix) __hip_atomic_fetch_add(hist + ((k >> shift) & (unsigned)(nb - 1)), 1, __ATOMIC_RELAXED, __HIP_MEMORY_SCOPE_WORKGROUP); }
            __syncthreads();
            int hb[8]; int ssum = 0;
#pragma unroll
            for (int i = 0; i < 8; ++i) { hb[i] = hist[tid * 8 + i]; ssum += hb[i]; }
            int suf = ssum;
#pragma unroll
            for (int o = 1; o < 64; o <<= 1) { const int t = __builtin_amdgcn_ds_bpermute(((lane + o) & 63) << 2, suf); if (lane + o < 64) suf += t; }
            if (lane == 0) wtot[wave] = suf;
            __syncthreads();
            int above_w = 0;
#pragma unroll
            for (int w = 0; w < 8; ++w) { const int t = wtot[w]; if (w > wave) above_w += t; }
            const int incl = above_w + suf, excl = incl - ssum;
            if (excl < krem && krem <= incl) {
                int run = excl, dig = 0, cab = 0;
#pragma unroll
                for (int i = 7; i >= 0; --i) { if (run < krem && krem <= run + hb[i]) { dig = tid * 8 + i; cab = run; } run += hb[i]; }
                wtot[8] = dig; wtot[9] = cab;
            }
            __syncthreads();
            prefix = (prefix << nbits) | (unsigned)wtot[8]; krem -= wtot[9];
        }
        const unsigned T = prefix;
        int g = 0, q = 0;
#pragma unroll
        for (int i = 0; i < 8; ++i) { g += (key[i] > T) ? 1 : 0; q += (key[i] == T) ? 1 : 0; }
        int pack = g | (q << 16), incl = pack;
#pragma unroll
        for (int o = 1; o < 64; o <<= 1) { const int t = __builtin_amdgcn_ds_bpermute(((lane - o) & 63) << 2, incl); if (lane >= o) incl += t; }
        if (lane == 63) cnts[16 + wave] = incl;
        __syncthreads();
        int wpre = 0, total = 0;
#pragma unroll
        for (int w = 0; w < 8; ++w) { const int t = cnts[16 + w]; total += t; if (w < wave) wpre += t; }
        const int excl = wpre + incl - pack;
        int g_run = excl & 0xffff, q_run = excl >> 16;
        const int need = KSEL - (total & 0xffff);
        const int posbase = isc ? (4 * CAP_L + b * CAP_C) : b * CAP_L;
        const int rowbase = isc ? NLAT + b * CTXL : b * SEQ;
        if (tid * 8 < n) {
#pragma unroll
            for (int i = 0; i < 8; ++i) {
                const int token = tid * 8 + i; int slot = -1;
                if (key[i] > T) { slot = g_run + (q_run < need ? q_run : need); ++g_run; }
                else if (key[i] == T) { if (q_run < need) slot = g_run + q_run; ++q_run; }
                F.INV()[(size_t)(rowbase + token) * 16 + e] = (short)(slot >= 0 ? posbase + slot : -1);
                if (slot >= 0) { F.ROWS()[e * EROWS + posbase + slot] = rowbase + token; F.GATE()[e * EROWS + posbase + slot] = __uint_as_float(key[i]); }
            }
        }
        if (!isc && b == 0 && tid < 128) { F.ROWS()[e * EROWS + 2176 + tid] = 0; F.GATE()[e * EROWS + 2176 + tid] = 0.f; }
        __syncthreads();
    }
}

__device__ __forceinline__ float log_gamma(const Frame& F, int l, int dir, int h) {
    const float x = F.in(10)[(l * 2 + dir) * 4 + h];
    return -log1pf(__expf(-x));
}
__device__ __forceinline__ void p3_conv(Frame& F, int l, const int gw, const int NGW) {
    const int nrows = (l == DEPTH - 1) ? NLAT : MROWS;
    const int c = 4 * F.lane;
    const f32x4 w0 = *(const f32x4*)(F.in(9) + (l * 3 + 0) * 256 + c), w1 = *(const f32x4*)(F.in(9) + (l * 3 + 1) * 256 + c), w2 = *(const f32x4*)(F.in(9) + (l * 3 + 2) * 256 + c);
    for (int r0 = gw * 4; r0 < nrows; r0 += NGW * 4) {
        int t0, len; if (r0 < NLAT) { t0 = r0 & (SEQ - 1); len = SEQ; } else { t0 = (r0 - NLAT) & (CTXL - 1); len = CTXL; }
        const bf16_t* p = F.PROJ() + (size_t)r0 * INW + c;
        u32x2 ca[6], cx[6], gb[4];
#pragma unroll
        for (int d = 0; d < 6; ++d) { const int tt = t0 + d - 1; const bool ok = (tt >= 0 && tt < len); const bf16_t* pp = p + (ptrdiff_t)(ok ? d - 1 : 0) * INW;
            ca[d] = *(const u32x2*)(pp + C_CC); cx[d] = *(const u32x2*)(pp + C_CX); if (!ok) { ca[d] = (u32x2){0u, 0u}; } }
#pragma unroll
        for (int d = 0; d < 4; ++d) gb[d] = *(const u32x2*)(p + (size_t)d * INW + C_CB);
        f32x4 z[6];
#pragma unroll
        for (int d = 0; d < 6; ++d) z[d] = (f32x4){bflo(ca[d].x) * bflo(cx[d].x), bfhi(ca[d].x) * bfhi(cx[d].x), bflo(ca[d].y) * bflo(cx[d].y), bfhi(ca[d].y) * bfhi(cx[d].y)};
#pragma unroll
        for (int d = 0; d < 4; ++d) {
            const f32x4 cv = z[d] * w0 + z[d + 1] * w1 + z[d + 2] * w2;
            const f32x4 o = (f32x4){bflo(gb[d].x), bfhi(gb[d].x), bflo(gb[d].y), bfhi(gb[d].y)} * cv;
            u32x2 w; w.x = pk2(o[0], o[1]); w.y = pk2(o[2], o[3]);
            *(u32x2*)(F.MIX() + (size_t)(r0 + d) * D + c) = w;
        }
    }
}
__device__ __forceinline__ int chunk_row0(int b, int u) { return u < 2 ? NLAT + b * CTXL + u * 128 : b * SEQ + (u - 2) * 128; }
struct UsLoad { u32x4 kq[2], vq[2]; };
__device__ __forceinline__ void p3_ustate_load(Frame& F, int b, int h, int u, UsLoad& L) {
    const int row0 = chunk_row0(b, u);
#pragma unroll
    for (int r = 0; r < 2; ++r) {
        const int idx = F.tid + r * NTHREADS, tok = idx >> 3, c = idx & 7;
        const bf16_t* p = F.PROJ() + (size_t)(row0 + tok) * INW + h * 64 + 8 * c;
        L.kq[r] = *(const u32x4*)(p + C_RK); L.vq[r] = *(const u32x4*)(p + C_RV);
    }
}
typedef short v4i16_t __attribute__((ext_vector_type(4)));
__device__ __forceinline__ bf16x8 tr_frag(const LAS unsigned char* img, int pitch, int r0, int c0, int lane) {
    const int i = lane & 15, g = lane >> 4;
    const LAS unsigned char* p = img + (r0 + 8 * g + (i >> 2)) * pitch + (c0 + 4 * (i & 3)) * 2;
    const v4i16_t lo = __builtin_amdgcn_ds_read_tr16_b64_v4i16((LAS v4i16_t*)p), hi = __builtin_amdgcn_ds_read_tr16_b64_v4i16((LAS v4i16_t*)(p + 4 * pitch));
    return (bf16x8){lo[0], lo[1], lo[2], lo[3], hi[0], hi[1], hi[2], hi[3]};
}
__device__ __forceinline__ void p3_ustate_stage(Frame& F, int l, int h, const UsLoad& L) {
    constexpr int PT = 144;
    LAS unsigned char* Kf = F.lds; LAS unsigned char* Kb = F.lds + 128 * PT; LAS unsigned char* Vs = F.lds + 256 * PT;
    const float lgf = log_gamma(F, l, 0, h) * LOG2E, lgb = log_gamma(F, l, 1, h) * LOG2E;
#pragma unroll
    for (int r = 0; r < 2; ++r) {
        const int idx = F.tid + r * NTHREADS, tok = idx >> 3, c = idx & 7;
        const float wf = fexp2(lgf * (float)(127 - tok)), wb = fexp2(lgb * (float)tok);
        u32x4 kf, kb;
#pragma unroll
        for (int i = 0; i < 4; ++i) { const unsigned kw = L.kq[r][i]; const float k0 = bflo(kw), k1 = bfhi(kw); kf[i] = pk2(k0 * wf, k1 * wf); kb[i] = pk2(k0 * wb, k1 * wb); }
        *(LAS u32x4*)(Kf + tok * PT + c * 16) = kf; *(LAS u32x4*)(Kb + tok * PT + c * 16) = kb; *(LAS u32x4*)(Vs + tok * PT + c * 16) = L.vq[r];
    }
}
__device__ __forceinline__ void p3_ustate_mma(Frame& F, int b, int h, int u) {
    constexpr int PT = 144;
    LAS unsigned char* Kf = F.lds; LAS unsigned char* Kb = F.lds + 128 * PT; LAS unsigned char* Vs = F.lds + 256 * PT;
    const int fr = F.lane & 15, fq = F.lane >> 4, dkt = F.wave >> 1;
#pragma unroll
    for (int dir = 0; dir < 2; ++dir) {
        LAS unsigned char* Ks = dir ? Kb : Kf;
#pragma unroll
        for (int dd = 0; dd < 2; ++dd) {
            const int dvt = (F.wave & 1) * 2 + dd;
            f32x4 acc = (f32x4){0.f, 0.f, 0.f, 0.f};
#pragma unroll
            for (int s = 0; s < 4; ++s) {
                const bf16x8 af = tr_frag(Ks, PT, 32 * s, dkt * 16, F.lane);
                const bf16x8 bf = tr_frag(Vs, PT, 32 * s, dvt * 16, F.lane);
                acc = __builtin_amdgcn_mfma_f32_16x16x32_bf16(af, bf, acc, 0, 0, 0);
            }
            float* up = F.U() + ((size_t)(((dir * BATCH + b) * 4 + h) * NCHUNK + u)) * 4096 + (dvt * 16 + fr) * 64 + dkt * 16 + 4 * fq;
            *(f32x4*)up = acc;
        }
    }
}
__device__ __forceinline__ void p3_ustates(Frame& F, int l, int first, int stride) {
    constexpr int NIT = BATCH * 4 * NCHUNK;
    if (first >= NIT) return;
    UsLoad L;
    p3_ustate_load(F, (first / NCHUNK) >> 2, (first / NCHUNK) & 3, first % NCHUNK, L);
    for (int it = first; it < NIT; it += stride) {
        const int u = it % NCHUNK, bh = it / NCHUNK;
        __syncthreads();
        p3_ustate_stage(F, l, bh & 3, L);
        __syncthreads();
        const int nx = it + stride;
        if (nx < NIT) p3_ustate_load(F, (nx / NCHUNK) >> 2, (nx / NCHUNK) & 3, nx % NCHUNK, L);
        p3_ustate_mma(F, bh >> 2, bh & 3, u);
    }
}
typedef float f32x16 __attribute__((ext_vector_type(16)));
#ifndef ATT_THR
#define ATT_THR 5.0f
#endif
__device__ __forceinline__ int crow(int reg, int h) { return (reg & 3) + 8 * (reg >> 2) + 4 * h; }
__device__ __forceinline__ void p3_attn_item(Frame& F, int l, int b, int kvh, int qb, bool is_ctx) {
    constexpr int PK = 144, PV = 136, BUF = 64 * PK + 64 * PV;
    const int lane = F.lane, r = lane & 31, h = lane >> 5, g = F.wave >> 1, hw = F.wave & 1, hq = kvh * 4 + g;
    const int tq0 = qb * 128 + hw * 64;
    const int qrow0 = is_ctx ? NLAT + b * CTXL + tq0 : b * SEQ + tq0;
    bf16x8 qf[2][4];
#pragma unroll
    for (int qt = 0; qt < 2; ++qt)
#pragma unroll
        for (int s = 0; s < 4; ++s) qf[qt][s] = *(const bf16x8*)(F.PROJ() + (size_t)(qrow0 + qt * 32 + r) * INW + C_AQ + hq * 64 + 16 * s + 8 * h);
    f32x16 o[2][2];
#pragma unroll
    for (int dt = 0; dt < 2; ++dt)
#pragma unroll
        for (int qt = 0; qt < 2; ++qt)
#pragma unroll
            for (int i = 0; i < 16; ++i) o[dt][qt][i] = 0.f;
    float mrun[2], lrun[2];
    const float sink = F.in(11)[l * 8 + hq];
#pragma unroll
    for (int qt = 0; qt < 2; ++qt) { mrun[qt] = sink; lrun[qt] = (h == 0) ? 1.0f : 0.0f; }
    const int ti0 = (!is_ctx && qb == 0) ? 2 : 0;
    const int nwin = is_ctx ? 0 : 6 - ti0 - ((qb == SEQ / 128 - 1) ? 2 : 0);
    const int ntile = nwin + 4;
    const int skey = F.tid >> 3, sc = F.tid & 7;
    u32x4 kq, vq;
#define ATT_ROWBASE(i) ((i) < nwin ? b * SEQ + qb * 128 - 128 + 64 * (ti0 + (i)) : NLAT + b * CTXL + 64 * ((i) - nwin))
#define ATT_LOAD(i) do { const bf16_t* p_ = F.PROJ() + (size_t)(ATT_ROWBASE(i) + skey) * INW + kvh * 64 + 8 * sc; kq = *(const u32x4*)(p_ + C_AK); vq = *(const u32x4*)(p_ + C_AV); } while (0)
#define ATT_STORE(buf) do { LAS unsigned char* Ks_ = F.lds + (buf) * BUF; LAS unsigned char* Vt_ = Ks_ + 64 * PK; \
        *(LAS u32x4*)(Ks_ + skey * PK + sc * 16) = kq; \
        _Pragma("unroll") for (int i_ = 0; i_ < 4; ++i_) { const unsigned vw_ = vq[i_]; \
            *(LAS bf16_t*)(Vt_ + (8 * sc + 2 * i_) * PV + skey * 2) = (bf16_t)(vw_ & 0xffffu); *(LAS bf16_t*)(Vt_ + (8 * sc + 2 * i_ + 1) * PV + skey * 2) = (bf16_t)(vw_ >> 16); } } while (0)
    ATT_LOAD(0);
    __syncthreads();
    ATT_STORE(0);
    int cur = 0;
    for (int it = 0; it < ntile; ++it) {
        __syncthreads();
        if (it + 1 < ntile) ATT_LOAD(it + 1);
        const bool win = it < nwin;
        const int ti = ti0 + it;
        const bool part = win ? (hw == 0 ? ti <= 4 : ti >= 1) : true;
        if (part) {
            const LAS unsigned char* Ks = F.lds + cur * BUF; const LAS unsigned char* Vt = Ks + 64 * PK;
            const bool mask = win && (hw == 0 ? (ti == 0 || ti == 4) : (ti == 1 || ti == 5));
            const int tk = qb * 128 - 128 + 64 * ti;
#pragma unroll
            for (int qt = 0; qt < 2; ++qt) {
                f32x16 st[2];
#pragma unroll
                for (int kt = 0; kt < 2; ++kt) {
#pragma unroll
                    for (int i = 0; i < 16; ++i) st[kt][i] = 0.f;
#pragma unroll
                    for (int s = 0; s < 4; ++s) { const bf16x8 kf = *(const LAS bf16x8*)(Ks + (kt * 32 + r) * PK + (16 * s + 8 * h) * 2); st[kt] = __builtin_amdgcn_mfma_f32_32x32x16_bf16(kf, qf[qt][s], st[kt], 0, 0, 0); }
                }
                if (mask) {
#pragma unroll
                    for (int kt = 0; kt < 2; ++kt)
#pragma unroll
                        for (int i = 0; i < 16; ++i) { const int dlt = (tq0 + qt * 32 + r) - (tk + kt * 32 + crow(i, h)); if (dlt > 128 || dlt < -128) st[kt][i] = -INFINITY; }
                }
                float mx = st[0][0];
#pragma unroll
                for (int kt = 0; kt < 2; ++kt)
#pragma unroll
                    for (int i = 0; i < 16; ++i) mx = fmaxf(mx, st[kt][i]);
                mx = max_x32(mx);
                float alpha = 1.0f;
                const bool resc = !__all(mx - mrun[qt] <= ATT_THR);
                if (resc) { const float mnew = fmaxf(mrun[qt], mx); alpha = fexp(mrun[qt] - mnew); mrun[qt] = mnew; }
                const float mneg = -mrun[qt] * LOG2E;
                float ps = 0.f;
                bf16x8 pb[2][2];
#pragma unroll
                for (int kt = 0; kt < 2; ++kt)
#pragma unroll
                    for (int s = 0; s < 2; ++s) {
                        float e[8];
#pragma unroll
                        for (int j = 0; j < 8; ++j) { e[j] = fexp2(st[kt][8 * s + j] * LOG2E + mneg); ps += e[j]; }
                        u32x4 w; w.x = pk2(e[0], e[1]); w.y = pk2(e[2], e[3]); w.z = pk2(e[4], e[5]); w.w = pk2(e[6], e[7]);
                        pb[kt][s] = __builtin_bit_cast(bf16x8, w);
                    }
                lrun[qt] = lrun[qt] * alpha + ps;
#pragma unroll
                for (int dt = 0; dt < 2; ++dt) {
                    if (resc) {
#pragma unroll
                        for (int i = 0; i < 16; ++i) o[dt][qt][i] *= alpha;
                    }
#pragma unroll
                    for (int kt = 0; kt < 2; ++kt)
#pragma unroll
                        for (int s = 0; s < 2; ++s) {
                            const LAS unsigned char* vp = Vt + (dt * 32 + r) * PV + (kt * 32 + 16 * s + 4 * h) * 2;
                            const u32x2 v0 = *(const LAS u32x2*)vp, v1 = *(const LAS u32x2*)(vp + 16);
                            u32x4 vw; vw.x = v0.x; vw.y = v0.y; vw.z = v1.x; vw.w = v1.y;
                            o[dt][qt] = __builtin_amdgcn_mfma_f32_32x32x16_bf16(__builtin_bit_cast(bf16x8, vw), pb[kt][s], o[dt][qt], 0, 0, 0);
                        }
                }
                __builtin_amdgcn_sched_barrier(0);
            }
        }
        if (it + 1 < ntile) ATT_STORE(cur ^ 1);
        cur ^= 1;
    }
#pragma unroll
    for (int qt = 0; qt < 2; ++qt) {
        const float inv = 1.0f / sum_x32(lrun[qt]);
        bf16_t* op = F.MIX() + (size_t)(qrow0 + qt * 32 + r) * D + 512 + hq * 64 + 4 * h;
#pragma unroll
        for (int dt = 0; dt < 2; ++dt)
#pragma unroll
            for (int g4 = 0; g4 < 4; ++g4) { u32x2 w; w.x = pk2(o[dt][qt][4 * g4] * inv, o[dt][qt][4 * g4 + 1] * inv); w.y = pk2(o[dt][qt][4 * g4 + 2] * inv, o[dt][qt][4 * g4 + 3] * inv);
                *(u32x2*)(op + dt * 32 + 8 * g4) = w; }
    }
#undef ATT_ROWBASE
#undef ATT_LOAD
#undef ATT_STORE
}
#ifndef ATT_REP
#define ATT_REP 1
#endif
#ifndef UST_REP
#define UST_REP 1
#endif
#ifndef CONV_REP
#define CONV_REP 1
#endif
__device__ __forceinline__ void p3_mix(Frame& F, int l) {
    const bool lastl = (l == DEPTH - 1);
    for (int rr = 0; rr < ATT_REP; ++rr) { const int it = F.vcu  ; const int b = it >> 6, kvh = (it >> 5) & 1, qb = it & 31; p3_attn_item(F, l, b, kvh, qb, false); }
    const int nlight = lastl ? 0 : 16;
    if (F.bid < nlight) { const int j = F.bid; p3_attn_item(F, l, j >> 2, (j >> 1) & 1, j & 1, true); }
    else {
        __syncthreads();
        const int lb = F.bid - nlight, nl = F.G - nlight;
        for (int rr = 0; rr < UST_REP; ++rr) p3_ustates(F, l, lb, nl);
        for (int rr = 0; rr < CONV_REP; ++rr)
        p3_conv(F, l, lb * NWAVES + F.wave, nl * NWAVES);
    }
}

__device__ __forceinline__ void p3b_scan(Frame& F, int l) {
    for (int idx = F.bid * NTHREADS + F.tid; idx < 2 * BATCH * 4 * 4096; idx += F.G * NTHREADS) {
        const int dir = idx >> 16, rem = idx & 65535, bh = rem >> 12, el = rem & 4095;
        const float dec = fexp2(log_gamma(F, l, dir, bh & 3) * LOG2E * 128.0f);
        const float* up = F.U() + (size_t)((dir * 16 + bh) * NCHUNK) * 4096 + el;
        bf16_t* sp = F.ST() + (size_t)((dir * 16 + bh) * NCHUNK) * 4096 + el;
        float uv[NCHUNK];
#pragma unroll
        for (int u = 0; u < NCHUNK; ++u) uv[u] = up[(size_t)u * 4096];
        float s = 0.f;
        if (dir == 0) {
#pragma unroll
            for (int u = 0; u < NCHUNK; ++u) { sp[(size_t)u * 4096] = (bf16_t)(pk2(s, 0.f) & 0xffffu); s = dec * s + uv[u]; }
        } else {
            sp[(size_t)1 * 4096] = (bf16_t)(pk2(s, 0.f) & 0xffffu); s = dec * s + uv[1];
            sp[(size_t)0 * 4096] = (bf16_t)(pk2(s, 0.f) & 0xffffu); s = dec * s + uv[0];
#pragma unroll
            for (int u = NCHUNK - 1; u >= 2; --u) { sp[(size_t)u * 4096] = (bf16_t)(pk2(s, 0.f) & 0xffffu); s = dec * s + uv[u]; }
        }
    }
}

__device__ __forceinline__ void p4_ret_item(Frame& F, int l, int b, int h, int u) {
    constexpr int PK = 144, PT = 272;
    LAS unsigned char* Ks = F.lds; LAS unsigned char* Vs = F.lds + 128 * PK; LAS unsigned char* Pw = F.lds + 256 * PK + F.wave * (16 * PT);
    const int lane = F.lane, fr = lane & 15, fq = lane >> 4;
    const int row0 = chunk_row0(b, u);
    const int qi = F.wave * 16 + fr;
    const int qrow = row0 + qi;
    u32x4 kq[2], vq[2];
#pragma unroll
    for (int r = 0; r < 2; ++r) {
        const int idx = F.tid + r * NTHREADS, tok = idx >> 3, c = idx & 7;
        const bf16_t* p = F.PROJ() + (size_t)(row0 + tok) * INW + h * 64 + 8 * c;
        kq[r] = *(const u32x4*)(p + C_RK); vq[r] = *(const u32x4*)(p + C_RV);
    }
    bf16x8 qf[2];
#pragma unroll
    for (int s = 0; s < 2; ++s) qf[s] = *(const bf16x8*)(F.PROJ() + (size_t)qrow * INW + C_RQ + h * 64 + 32 * s + 8 * fq);
    u32x2 gq[2][4]; bf16x8 sf[2][2][4];
#pragma unroll
    for (int dir = 0; dir < 2; ++dir) {
        const bf16_t* gp = F.PROJ() + (size_t)qrow * INW + (dir == 0 ? C_RGF : C_RGB) + h * 64 + 4 * fq;
        const bf16_t* stp = F.ST() + (size_t)(((dir * BATCH + b) * 4 + h) * NCHUNK + u) * 4096;
#pragma unroll
        for (int dt = 0; dt < 4; ++dt) { gq[dir][dt] = *(const u32x2*)(gp + dt * 16);
#pragma unroll
            for (int s = 0; s < 2; ++s) sf[dir][s][dt] = *(const bf16x8*)(stp + (dt * 16 + fr) * 64 + 32 * s + 8 * fq); }
    }
    __syncthreads();
#pragma unroll
    for (int r = 0; r < 2; ++r) {
        const int idx = F.tid + r * NTHREADS, tok = idx >> 3, c = idx & 7;
        *(LAS u32x4*)(Ks + tok * PK + c * 16) = kq[r]; *(LAS u32x4*)(Vs + tok * PK + c * 16) = vq[r];
    }
    __syncthreads();
    f32x4 st[8];
#pragma unroll
    for (int kt = 0; kt < 8; ++kt) {
        const bf16x8 k0 = *(const LAS bf16x8*)(Ks + (kt * 16 + fr) * PK + (8 * fq) * 2), k1 = *(const LAS bf16x8*)(Ks + (kt * 16 + fr) * PK + (32 + 8 * fq) * 2);
        f32x4 z = (f32x4){0.f, 0.f, 0.f, 0.f};
        z = __builtin_amdgcn_mfma_f32_16x16x32_bf16(k0, qf[0], z, 0, 0, 0);
        st[kt] = __builtin_amdgcn_mfma_f32_16x16x32_bf16(k1, qf[1], z, 0, 0, 0);
    }
    f32x4 res[4];
#pragma unroll
    for (int dt = 0; dt < 4; ++dt) res[dt] = (f32x4){0.f, 0.f, 0.f, 0.f};
#pragma unroll
    for (int dir = 0; dir < 2; ++dir) {
        const float lg2 = log_gamma(F, l, dir, h) * LOG2E;
#pragma unroll
        for (int kt = 0; kt < 8; ++kt) {
            f32x4 p;
#pragma unroll
            for (int r = 0; r < 4; ++r) { const int j = kt * 16 + 4 * fq + r; const int df = dir == 0 ? qi - j : j - qi; p[r] = df >= 0 ? st[kt][r] * fexp2(lg2 * (float)df) : 0.f; }
            u32x2 w; w.x = pk2(p[0], p[1]); w.y = pk2(p[2], p[3]);
            *(LAS u32x2*)(Pw + fr * PT + (kt * 16 + 4 * fq) * 2) = w;
        }
        f32x4 o[4];
#pragma unroll
        for (int dt = 0; dt < 4; ++dt) o[dt] = (f32x4){0.f, 0.f, 0.f, 0.f};
#pragma unroll
        for (int s = 0; s < 4; ++s) {
            const bf16x8 pf = *(const LAS bf16x8*)(Pw + fr * PT + (32 * s + 8 * fq) * 2);
#pragma unroll
            for (int dt = 0; dt < 4; ++dt) { const bf16x8 vf = tr_frag(Vs, PK, 32 * s, dt * 16, lane); o[dt] = __builtin_amdgcn_mfma_f32_16x16x32_bf16(vf, pf, o[dt], 0, 0, 0); }
        }
        f32x4 tt[4];
#pragma unroll
        for (int dt = 0; dt < 4; ++dt) tt[dt] = (f32x4){0.f, 0.f, 0.f, 0.f};
#pragma unroll
        for (int s = 0; s < 2; ++s)
#pragma unroll
            for (int dt = 0; dt < 4; ++dt) tt[dt] = __builtin_amdgcn_mfma_f32_16x16x32_bf16(sf[dir][s][dt], qf[s], tt[dt], 0, 0, 0);
        const float qdec = fexp2(lg2 * (float)(dir == 0 ? qi + 1 : 128 - qi));
        float sm = 0.f;
#pragma unroll
        for (int dt = 0; dt < 4; ++dt) { o[dt] = o[dt] + tt[dt] * qdec; sm += (o[dt][0] + o[dt][1]) + (o[dt][2] + o[dt][3]); }
        sm = sum_x16(sm); sm = sum_x32(sm);
        const float mean = sm * (1.0f / 64.0f);
        float vr = 0.f;
#pragma unroll
        for (int dt = 0; dt < 4; ++dt) { o[dt] = o[dt] - mean; vr += (o[dt][0] * o[dt][0] + o[dt][1] * o[dt][1]) + (o[dt][2] * o[dt][2] + o[dt][3] * o[dt][3]); }
        vr = sum_x16(vr); vr = sum_x32(vr);
        const float rstd = 1.0f / sqrtf(vr * (1.0f / 64.0f) + EPS);
#pragma unroll
        for (int dt = 0; dt < 4; ++dt) { const u32x2 g_ = gq[dir][dt];
            const f32x4 gv = (f32x4){bflo(g_.x), bfhi(g_.x), bflo(g_.y), bfhi(g_.y)};
#pragma unroll
            for (int r = 0; r < 4; ++r) res[dt][r] += o[dt][r] * rstd * silu_f(gv[r]); }
    }
    bf16_t* op = F.MIX() + (size_t)qrow * D + 256 + h * 64 + 4 * fq;
#pragma unroll
    for (int dt = 0; dt < 4; ++dt) { u32x2 w; w.x = pk2(res[dt][0], res[dt][1]); w.y = pk2(res[dt][2], res[dt][3]); *(u32x2*)(op + dt * 16) = w; }
}
__device__ __forceinline__ void p4_readout(Frame& F, int l) {
    const int u0 = (l == DEPTH - 1) ? 2 : 0, nu = NCHUNK - u0;
    for (int it = F.bid; it < BATCH * 4 * nu; it += F.G) { const int u = u0 + it % nu, bh = it / nu; p4_ret_item(F, l, bh >> 2, bh & 3, u); }
}

constexpr int NK = 8;
constexpr int NPHASE = 2 + NK * DEPTH;
#ifndef PH_EN
#define PH_EN(k) 1
#endif
#ifndef PH_REP
#define PH_REP(k) 1
#endif

__global__ void __launch_bounds__(NTHREADS, 2) fwd_kernel(Args args) {
    extern __shared__ __attribute__((aligned(16))) unsigned char lds[];
    for (int u = threadIdx.x; u < (LDS_BYTES - LDSCTL_OFF) / 4; u += NTHREADS) ((LAS unsigned*)((LAS unsigned char*)lds + LDSCTL_OFF))[u] = 0u;
    __syncthreads();
    const int wslot = __builtin_amdgcn_readfirstlane((int)(threadIdx.x >> 6));
    const int lo = args.ph_lo, hi = args.ph_hi;
    volatile LAS unsigned* MISC = (volatile LAS unsigned*)((LAS unsigned char*)lds + MISC_OFF);
    XcdBarrier bar; bar.bar = (unsigned*)(args.ws + WS_CTL) + CW_BAR; bar.x = 0; bar.st = MISC + 8;
    if (hi - lo > 1) bar = xcd_barrier_post((unsigned*)(args.ws + WS_CTL) + CW_BAR, MISC + 8, wslot == 0 && __builtin_amdgcn_mbcnt_hi(~0u, __builtin_amdgcn_mbcnt_lo(~0u, 0u)) == 0);
    int ph = lo, rep = 0;
    while (ph < hi) {
        Frame F;
        F.lds = (LAS unsigned char*)lds;
        unsigned allm = ~0u; asm volatile("" : "+s"(allm));
        int ptid = wslot * 64 + (int)__builtin_amdgcn_mbcnt_hi(allm, __builtin_amdgcn_mbcnt_lo(allm, 0u)), pbid = blockIdx.x;
        F.ws = args.ws; F.ap = (const Args*)(uintptr_t)__builtin_amdgcn_kernarg_segment_ptr();
        asm volatile("" : "+s"(F.ws), "+s"(F.ap), "+v"(ptid), "+s"(pbid));
        F.tid = ptid; F.lane = ptid & 63; F.wave = __builtin_amdgcn_readfirstlane(ptid >> 6); F.bid = pbid;
        F.G = gridDim.x; F.vcu = (F.G % 8 == 0) ? (pbid % 8) * (F.G / 8) + pbid / 8 : pbid;
        const int kind = (ph == 0) ? 10 : (ph == NPHASE - 1) ? 0 : (ph - 1) % NK;
        int nrep = PH_REP(0);
#pragma unroll
        for (int kk = 1; kk <= 10; ++kk) if (kind == kk) nrep = PH_REP(kk);
        if (ph == 0) { if (PH_EN(10)) p0_prologue(F); }
        else if (ph == NPHASE - 1) { if (PH_EN(0)) p1_rows<false>(F, DEPTH); }
        else {
            const int l = (ph - 1) / NK, k = (ph - 1) % NK;
            const bool lastl = (l == DEPTH - 1);
            if (k == 0) { if (PH_EN(0)) { if (l == 0) p1_rows<true>(F, l); else p1_rows<false>(F, l); } }
            else if (k == 1) { if (PH_EN(1)) {
                SchedDense S{MROWS / 256, INW / 256, (MROWS / 256) * (INW / 256), F.G, F.bid, (const char*)F.H(), (const char*)(F.WIN() + (size_t)l * INW * 1024), 1024};
                LAS float* lrope = (LAS float*)(F.lds + LDSCTL_OFF + 1024);
                ((LAS f32x4*)lrope)[F.tid] = ((const f32x4*)F.ROPE())[F.tid];
                __syncthreads();
                EpiIn E{F.PROJ(), lrope};
                pg8::gemm_phase(F.lds, F.tid, 1024, S, E);
            } }
            else if (k == 2) { if (PH_EN(2)) p3_mix(F, l); }
            else if (k == 3) { if (PH_EN(3)) p3b_scan(F, l); }
            else if (k == 4) { if (PH_EN(4)) p4_readout(F, l); }
            else if (k == 5) { if (PH_EN(5)) {
                unsigned* cnt5 = F.ctl() + CW_C5 + l * 128 * 64;
                SchedOut S{256, F.G, F.bid, (const char*)F.MIX(), (const char*)(F.WOUT() + (size_t)l * 1024 * 1024), cnt5};
                EpiOut E{Y1buf(F), F.MOD() + (size_t)l * 5 * 6144};
#ifndef OUT_REP
#define OUT_REP 1
#endif
#ifndef ROWS2_REP
#define ROWS2_REP 1
#endif
                for (int rr = 0; rr < OUT_REP; ++rr) pg8::gemm_phase(F.lds, F.tid, 1024, S, E);
                if (!lastl) p5_ctx_piece(F, l, cnt5);
                for (int rr = 0; rr < ROWS2_REP; ++rr) { if (rr) __syncthreads(); p6_rows<false>(F, l, cnt5); }
            } }
            else if (k == 6) { if (PH_EN(6)) p7_topk(F, l); }
            else { if (PH_EN(7)) {
                const int nM = lastl ? 8 : 9;
                constexpr size_t ESZ = FFN_FP8 ? 1 : 2;
                LAS int* lrows = (LAS int*)(F.lds + LDSCTL_OFF + 1024);
                SchedFfn S{nM, NE * nM * 8, NE * nM * 4, F.G, F.bid, (const char*)F.H(), (const char*)F.ACT(), (const char*)F.WGU() + (size_t)l * NE * 2048 * 1024 * ESZ, (const char*)F.WD() + (size_t)l * NE * 1024 * 1024 * ESZ,
                           lrows, F.ctl() + CW_C8 + l * 144 * 64};
                { pg8::Unit pu_; for (int i = 0; i < 5 && S.next(i, pu_); ++i) if ((pu_.t & 1) == 0 && F.tid < 256) lrows[i * 256 + F.tid] = F.ROWS()[pu_.e * EROWS + pu_.pm * 256 + F.tid]; }
                __syncthreads();
                EpiFfn E{(void*)F.ACT(), F.YB(), F.GATE()};
                pg8::gemm_phase(F.lds, F.tid, FFN_FP8 ? 512 : 1024, S, E);
            } }
        }
        if (++rep >= nrep) { rep = 0; ++ph; }
        if (ph < hi) xcd_barrier(bar, F.tid == 0);
    }
}

extern "C" void kernel_launch(void* const* d_in, const int* in_sizes, int n_in, void* d_out, int out_size, void* d_ws, size_t ws_size, hipStream_t stream) {
    static int grid = 0;
    if (grid == 0) {
        if (n_in != 18 || in_sizes[0] != NLAT * D || out_size != NLAT * D || ws_size < WS_END) {
            fprintf(stderr, "kernel_launch: unexpected shapes (n_in %d, in0 %d, out %d, ws %zu; need ws >= %zu); nothing launched\n", n_in, n_in > 0 ? in_sizes[0] : -1, out_size, ws_size, (size_t)WS_END);
            grid = -1; return; }
        int dev = 0, cus = 0, per_cu = 0;
        if (hipGetDevice(&dev) != hipSuccess || hipDeviceGetAttribute(&cus, hipDeviceAttributeMultiprocessorCount, dev) != hipSuccess) { grid = -1; return; }
        if (hipFuncSetAttribute((const void*)fwd_kernel, hipFuncAttributeMaxDynamicSharedMemorySize, LDS_BYTES) != hipSuccess) { fprintf(stderr, "kernel_launch: hipFuncSetAttribute failed\n"); grid = -1; return; }
        if (hipOccupancyMaxActiveBlocksPerMultiprocessor(&per_cu, (const void*)fwd_kernel, NTHREADS, LDS_BYTES) != hipSuccess || per_cu < 1)
            fprintf(stderr, "kernel_launch: note: occupancy query reports %d workgroups per CU\n", per_cu);
        (void)hipGetLastError();
        grid = cus;
    }
    if (grid < 0) return;
    if (hipMemsetAsync((char*)d_ws + WS_CTL, 0, CTL_ZERO_BYTES, stream) != hipSuccess) { fprintf(stderr, "kernel_launch: memset failed\n"); return; }
    Args a{};
    for (int i = 0; i < 18; ++i) a.in[i] = (const float*)d_in[i];
    a.out = (float*)d_out; a.ws = (unsigned char*)d_ws;
#if MK_PER_PHASE
    for (int ph = 0; ph < NPHASE; ++ph) {
        a.ph_lo = ph; a.ph_hi = ph + 1;
        hipLaunchKernelGGL(fwd_kernel, dim3(grid), dim3(NTHREADS), LDS_BYTES, stream, a);
    }
#else
    a.ph_lo = 0; a.ph_hi = NPHASE;
    void* kargs[] = {&a};
    hipError_t e = hipLaunchCooperativeKernel((const void*)fwd_kernel, dim3(grid), dim3(NTHREADS), kargs, LDS_BYTES, stream);
    if (e != hipSuccess) fprintf(stderr, "kernel_launch: cooperative launch failed: %s (grid %d)\n", hipGetErrorString(e), grid);
#endif
}
```

```cpp
#include <hip/hip_runtime.h>
#include <hip/hip_cooperative_groups.h>
#include <cstdio>
#include <cstdint>

#ifndef FFN_FP8
#define FFN_FP8 1
#endif
#ifndef MK_PER_PHASE
#define MK_PER_PHASE 0
#endif

#define GAS __attribute__((address_space(1)))
#define LAS __attribute__((address_space(3)))
typedef unsigned short bf16_t;
typedef short bf16x8 __attribute__((ext_vector_type(8)));
typedef float f32x4 __attribute__((ext_vector_type(4)));
typedef float f32x2 __attribute__((ext_vector_type(2)));
typedef unsigned u32x4 __attribute__((ext_vector_type(4)));
typedef unsigned u32x2 __attribute__((ext_vector_type(2)));
typedef __bf16 bf16x2_t __attribute__((ext_vector_type(2)));

constexpr int D = 1024, BATCH = 4, SEQ = 4096, DEPTH = 4, CTXL = 256;
constexpr int NLAT = BATCH * SEQ, NCTX = BATCH * CTXL, MROWS = NLAT + NCTX;
constexpr int INW = 2816;
constexpr int C_CB = 0, C_CC = 256, C_CX = 512, C_RQ = 768, C_RK = 1024, C_RV = 1280, C_RGF = 1536, C_RGB = 1792, C_AQ = 2048, C_AK = 2560, C_AV = 2688;
constexpr int NE = 16, CAP_L = 512, CAP_C = 32, EROWS = 2304;
constexpr int NCHUNK = 34;
constexpr float EPS = 1e-6f;
constexpr float LOG2E = 1.4426950408889634f;

constexpr size_t MiB = 1u << 20;
constexpr size_t WS_CTL = 0, CTL_ZERO_BYTES = 512 * 1024;
constexpr size_t WS_MOD = 1 * MiB;
constexpr size_t WS_ROPE = 1 * MiB + 512 * 1024;
constexpr size_t WS_AFF = 2 * MiB;
constexpr size_t WS_ROWS = 4 * MiB;
constexpr size_t WS_GATE = 4 * MiB + 256 * 1024;
constexpr size_t WS_INV = 5 * MiB;
constexpr size_t WS_X = 8 * MiB;
constexpr size_t WS_H = 76 * MiB;
constexpr size_t WS_PROJ = 110 * MiB;
constexpr size_t WS_MIX = 204 * MiB;
constexpr size_t WS_U = 238 * MiB;
constexpr size_t WS_ST = 256 * MiB;
constexpr size_t WS_ACT = 266 * MiB;
constexpr size_t WS_YB = 338 * MiB;
constexpr size_t WS_WIN = 410 * MiB;
constexpr size_t WS_WOUT = 432 * MiB;
constexpr size_t WS_WGU = 440 * MiB;
constexpr size_t WS_WD = 696 * MiB;
constexpr size_t WS_X1 = 824 * MiB;
constexpr size_t WS_END = 892 * MiB;
constexpr int CW_BAR = 4096;

constexpr int RING_BYTES = 131072;
constexpr int LDSCTL_OFF = RING_BYTES, MISC_OFF = LDSCTL_OFF + 320;
constexpr int LDS_BYTES = 147456;
constexpr int NWAVES = 8, NTHREADS = 512;

__device__ __forceinline__ unsigned pk2(float lo, float hi) { f32x2 v = {lo, hi}; bf16x2_t b = __builtin_convertvector(v, bf16x2_t); return __builtin_bit_cast(unsigned, b); }
__device__ __forceinline__ float bflo(unsigned w) { return __uint_as_float(w << 16); }
__device__ __forceinline__ float bfhi(unsigned w) { return __uint_as_float(w & 0xffff0000u); }
__device__ __forceinline__ float fexp2(float x) { return __builtin_amdgcn_exp2f(x); }
__device__ __forceinline__ float fexp(float x) { return __builtin_amdgcn_exp2f(x * LOG2E); }
__device__ __forceinline__ float silu_f(float x) { return x / (1.0f + __expf(-x)); }
__device__ __forceinline__ float shx(float v, int o, int lane) { return __uint_as_float((unsigned)__builtin_amdgcn_ds_bpermute((lane ^ o) << 2, (int)__float_as_uint(v))); }
__device__ __forceinline__ int shxi(int v, int o, int lane) { return __builtin_amdgcn_ds_bpermute((lane ^ o) << 2, v); }
__device__ __forceinline__ float sum_x32(float v) { auto r = __builtin_amdgcn_permlane32_swap(__float_as_uint(v), __float_as_uint(v), false, false); return __uint_as_float(r[0]) + __uint_as_float(r[1]); }
__device__ __forceinline__ float sum_x16(float v) { auto r = __builtin_amdgcn_permlane16_swap(__float_as_uint(v), __float_as_uint(v), false, false); return __uint_as_float(r[0]) + __uint_as_float(r[1]); }
__device__ __forceinline__ float max_x32(float v) { auto r = __builtin_amdgcn_permlane32_swap(__float_as_uint(v), __float_as_uint(v), false, false); return fmaxf(__uint_as_float(r[0]), __uint_as_float(r[1])); }
__device__ __forceinline__ float max_x16(float v) { auto r = __builtin_amdgcn_permlane16_swap(__float_as_uint(v), __float_as_uint(v), false, false); return fmaxf(__uint_as_float(r[0]), __uint_as_float(r[1])); }
__device__ __forceinline__ float wave_sum(float v, int lane) {
    v += shx(v, 1, lane); v += shx(v, 2, lane); v += shx(v, 4, lane); v += shx(v, 8, lane); v = sum_x16(v); v = sum_x32(v);
    return v;
}
#define LDS_WAIT() asm volatile("s_waitcnt lgkmcnt(0)" ::: "memory")
#define VM_WAIT() asm volatile("s_waitcnt vmcnt(0)" ::: "memory")

#define XB_TMO      128
#define XB_XCNT(j)  (256  + 64 * (j))
#define XB_XSUB(j)  (1280 + 64 * (j))
#define XB_XGEN(j)  (2304 + 64 * (j))
#define XB_TOP      3328
#define XB_TOPGEN   3392
#define XCD_BAR_WORDS 3456
#define XB_SPIN_CAP (1u << 22)
__device__ __forceinline__ unsigned xb_ld(unsigned* p)              { return __hip_atomic_load(p, __ATOMIC_RELAXED, __HIP_MEMORY_SCOPE_AGENT); }
__device__ __forceinline__ unsigned xb_add(unsigned* p, unsigned v) { return __hip_atomic_fetch_add(p, v, __ATOMIC_RELAXED, __HIP_MEMORY_SCOPE_AGENT); }
__device__ __forceinline__ unsigned xb_xcc_id() { return (unsigned)__builtin_amdgcn_s_getreg((3 << 11) | 20) & 0xFu; }
#define XB_SPIN(cond, bar) do { unsigned _sp = 0; while (cond) { __builtin_amdgcn_s_sleep(1); \
    if ((++_sp & 255u) == 0u) { if (xb_ld(&(bar)[XB_TMO])) break; if (_sp > XB_SPIN_CAP) { atomicAdd(&(bar)[XB_TMO], 1u); break; } } } } while (0)
struct XcdBarrier { unsigned* bar; unsigned x; volatile LAS unsigned* st; };
__device__ __forceinline__ XcdBarrier xcd_barrier_post(unsigned* bar, volatile LAS unsigned* st, bool leader) {
    XcdBarrier b; b.bar = bar; b.x = xb_xcc_id(); b.st = st;
    if (leader) (void)xb_add(&bar[XB_XCNT(b.x)], 1u);
    return b;
}
__device__ __forceinline__ void xcd_barrier_complete(unsigned* bar, unsigned x, unsigned& nloc, unsigned& nx) {
    const unsigned G = gridDim.x * gridDim.y * gridDim.z;
    unsigned sum, cnt, mine, sp = 0u;
    for (;;) {
        sum = 0u; cnt = 0u; mine = 0u;
#pragma unroll
        for (unsigned j = 0; j < 16; ++j) { const unsigned c = xb_ld(&bar[XB_XCNT(j)]); sum += c; cnt += (c > 0u) ? 1u : 0u; mine = (j == x) ? c : mine; }
        if (sum == G) break;
        __builtin_amdgcn_s_sleep(1);
        if ((++sp & 255u) == 0u) { if (xb_ld(&bar[XB_TMO])) break; if (sp > XB_SPIN_CAP) { atomicAdd(&bar[XB_TMO], 1u); break; } }
    }
    nloc = mine > 0u ? mine : 1u; nx = cnt > 0u ? cnt : 1u;
}
__device__ __forceinline__ void xcd_barrier(const XcdBarrier& b, bool leader) {
    asm volatile("s_waitcnt vmcnt(0)" ::: "memory");
    __syncthreads();
    if (leader) {
        unsigned* bar = b.bar;
        __builtin_amdgcn_s_waitcnt(0);
        unsigned nloc = b.st[0], nx = b.st[1];
        if (nloc == 0u) { xcd_barrier_complete(bar, b.x, nloc, nx); b.st[0] = nloc; b.st[1] = nx; }
        const unsigned old = xb_add(&bar[XB_XSUB(b.x)], 1u);
        const unsigned gen = old / nloc;
        if (old + 1u == (gen + 1u) * nloc) {
            __builtin_amdgcn_fence(__ATOMIC_RELEASE, "agent");
            asm volatile("s_waitcnt vmcnt(0)" ::: "memory");
            const unsigned og = xb_add(&bar[XB_TOP], 1u);
            const unsigned tg = og / nx;
            if (og + 1u == (tg + 1u) * nx) xb_add(&bar[XB_TOPGEN], 1u);
            else XB_SPIN(xb_ld(&bar[XB_TOPGEN]) == tg, bar);
            __builtin_amdgcn_fence(__ATOMIC_ACQUIRE, "agent");
            xb_add(&bar[XB_XGEN(b.x)], 1u);
            asm volatile("s_waitcnt vmcnt(0)" ::: "memory");
        } else {
            XB_SPIN(xb_ld(&bar[XB_XGEN(b.x)]) == gen, bar);
            __builtin_amdgcn_fence(__ATOMIC_ACQUIRE, "agent");
            asm volatile("s_waitcnt vmcnt(0)" ::: "memory");
        }
    }
    __syncthreads();
}

namespace pg8 {
constexpr int BM = 256, BK = 64, HALF = 128, HTB = HALF * BK * 2, STAGE_BYTES = 8 * HTB, NXCD = 8, WGM = 8;
__host__ __device__ __forceinline__ int lds_byte(int r, int c) { const int st = (r >> 4) * 2 + (c >> 5), rr = r & 15, cc = c & 31, ob = rr * 64 + cc * 2; return st * 1024 + (ob ^ (((ob >> 9) & 1) << 5)); }
__host__ __device__ __forceinline__ void stage_rc(int b, int& R, int& C) { const int st = b / 1024, sb = b % 1024, swz = sb ^ (((sb >> 9) & 1) << 5); R = (st >> 1) * 16 + swz / 64; C = (st & 1) * 32 + (swz % 64) / 2; }
__host__ __device__ __forceinline__ int perm32(int rho) { const int n = rho >> 4, i = rho & 15; return 8 * (i >> 2) + 4 * n + (i & 3); }
struct Unit { int pm, pn, e, t; };
typedef int v4i_t __attribute__((ext_vector_type(4)));
typedef int v8i_t __attribute__((ext_vector_type(8)));

template <class Epi, class Sched>
__device__ __forceinline__ void gemm_phase(LAS unsigned char* lds, const int tid, const int K, const Sched& S, const Epi& E) {
    const int wid = __builtin_amdgcn_readfirstlane(tid >> 6), lane = tid & 63, wr = wid >> 2, wc = wid & 3, fr = lane & 15, fq = lane >> 4;
    const int nt = K / BK;
    int Rr[2]; unsigned cb[2], voffB[2];
#pragma unroll
    for (int i = 0; i < 2; ++i) { int R, C; stage_rc(tid * 16 + i * 8192, R, C); Rr[i] = R; cb[i] = (unsigned)C * 2u; const int Rb = Epi::PERM ? ((R & ~31) + perm32(R & 31)) : R; voffB[i] = (unsigned)(Rb * K + C) * 2u; }
    const size_t kstep = (size_t)(BK * 2);
    const size_t hstep = (size_t)HALF * K * 2;
    const unsigned rowb = (unsigned)K * 2u;
    const unsigned ldsw = (unsigned)wid * 1024u;
    const int aoff = lds_byte(wr * 64 + fr, fq * 8), boff = lds_byte(wc * 32 + fr, fq * 8);
#define PG8_SA(b, h) (((b) * 2 + (h)) * HTB)
#define PG8_SB(b, h) ((4 + (b) * 2 + (h)) * HTB)
#define PG8_STAGE(bufoff, gbase, voff) do { _Pragma("unroll") for (int _i = 0; _i < 2; ++_i) \
        __builtin_amdgcn_global_load_lds((const unsigned*)((const char*)(gbase) + (voff)[_i]), (LAS unsigned*)(lds + (bufoff) + ldsw + _i * 8192), 16, 0, 0); } while (0)
#define PG8_LDA(dst, b, h) do { if constexpr (Epi::FP8) { _Pragma("unroll") for (int m = 0; m < 4; ++m) dst##8[m] = __builtin_shufflevector(*(const LAS v4i_t*)(lds + PG8_SA(b, h) + aoff + m * 2048), *(const LAS v4i_t*)(lds + PG8_SA(b, h) + aoff + m * 2048 + 1024), 0, 1, 2, 3, 4, 5, 6, 7); } \
        else { _Pragma("unroll") for (int m = 0; m < 4; ++m) _Pragma("unroll") for (int k = 0; k < 2; ++k) dst[m][k] = *(const LAS bf16x8*)(lds + PG8_SA(b, h) + aoff + m * 2048 + k * 1024); } } while (0)
#define PG8_LDB(dst, b, h) do { if constexpr (Epi::FP8) { _Pragma("unroll") for (int n = 0; n < 2; ++n) dst##8[n] = __builtin_shufflevector(*(const LAS v4i_t*)(lds + PG8_SB(b, h) + boff + n * 2048), *(const LAS v4i_t*)(lds + PG8_SB(b, h) + boff + n * 2048 + 1024), 0, 1, 2, 3, 4, 5, 6, 7); } \
        else { _Pragma("unroll") for (int n = 0; n < 2; ++n) _Pragma("unroll") for (int k = 0; k < 2; ++k) dst[n][k] = *(const LAS bf16x8*)(lds + PG8_SB(b, h) + boff + n * 2048 + k * 1024); } } while (0)
#define PG8_MMA(ai, bj, At, Bt) do { __builtin_amdgcn_s_setprio(1); \
        if constexpr (Epi::FP8) { _Pragma("unroll") for (int m = 0; m < 4; ++m) _Pragma("unroll") for (int n = 0; n < 2; ++n) \
            asm volatile("v_mfma_scale_f32_16x16x128_f8f6f4 %0, %1, %2, %0, %3, %3 op_sel_hi:[0,0,0]" : "+v"(acc[ai][bj][m][n]) : "v"(Bt##8[n]), "v"(At##8[m]), "v"(sc1v)); } \
        else { _Pragma("unroll") for (int m = 0; m < 4; ++m) _Pragma("unroll") for (int n = 0; n < 2; ++n) _Pragma("unroll") for (int k = 0; k < 2; ++k) \
            acc[ai][bj][m][n] = __builtin_amdgcn_mfma_f32_16x16x32_bf16(Bt[n][k], At[m][k], acc[ai][bj][m][n], 0, 0, 0); } \
        __builtin_amdgcn_s_setprio(0); } while (0)
#define PG8_WAIT_V(n) asm volatile("s_waitcnt vmcnt(" #n ")" ::: "memory")
#define PG8_WAIT_L(n) asm volatile("s_waitcnt lgkmcnt(" #n ")" ::: "memory")
#define PG8_BAR __builtin_amdgcn_s_barrier()
#define PG8_SCHED __builtin_amdgcn_sched_barrier(0)
#define PG8_AOFFS(u, o0, o1) do { _Pragma("unroll") for (int _i = 0; _i < 2; ++_i) { o0[_i] = (unsigned)S.arow(u, Rr[_i]) * rowb + cb[_i]; o1[_i] = (unsigned)S.arow(u, HALF + Rr[_i]) * rowb + cb[_i]; } } while (0)
    Unit cur, nxt, pu; int ui = 0; bool pend = false;
    if (!S.next(0, cur)) return;
    pu = cur;
    f32x4 acc[2][2][4][2];
#pragma unroll
    for (int a = 0; a < 2; ++a)
#pragma unroll
        for (int b = 0; b < 2; ++b)
#pragma unroll
            for (int m = 0; m < 4; ++m)
#pragma unroll
                for (int n = 0; n < 2; ++n) acc[a][b][m][n] = (f32x4){0.f, 0.f, 0.f, 0.f};
    bf16x8 At[4][2], B0[2][2], B1[2][2];
    v8i_t At8[4], B08[2], B18[2];
    int sc1v = 0x7f7f7f7f; asm volatile("" : "+v"(sc1v));
    unsigned c0[2], c1[2], n0[2], n1[2];
    S.a_ready(cur, tid);
    PG8_AOFFS(cur, c0, c1);
    const char* cB = S.bbase(cur); const char* cA = S.abase(cur);
    PG8_STAGE(PG8_SB(0, 0), cB, voffB); PG8_STAGE(PG8_SB(0, 1), cB + hstep, voffB); PG8_STAGE(PG8_SA(0, 0), cA, c0); PG8_STAGE(PG8_SA(0, 1), cA, c1);
    if (wr == 1) PG8_BAR;
    PG8_WAIT_V(2); PG8_BAR;
    PG8_STAGE(PG8_SB(1, 0), cB + kstep, voffB); PG8_STAGE(PG8_SA(1, 0), cA + kstep, c0); PG8_STAGE(PG8_SB(1, 1), cB + hstep + kstep, voffB);
    PG8_WAIT_V(6); PG8_BAR;
    for (;;) {
        const bool has_next = S.next(ui + 1, nxt);
        const char* nB = cB; const char* nA = cA;
        if (has_next) { PG8_AOFFS(nxt, n0, n1); nB = S.bbase(nxt); nA = S.abase(nxt); }
        else {
#pragma unroll
            for (int i = 0; i < 2; ++i) { n0[i] = c0[i]; n1[i] = c1[i]; }
        }
        for (int t = 0; t < nt; t += 2) {
            const bool last = (t == nt - 2);
            if (last && has_next) S.a_ready(nxt, tid);
            const char* a1 = cA + (size_t)(t + 1) * kstep;
            const char* a2 = last ? nA : cA + (size_t)(t + 2) * kstep; const char* b2 = last ? nB : cB + (size_t)(t + 2) * kstep;
            const char* a3 = a2 + kstep; const char* b3 = b2 + kstep;
            unsigned x0[2], x1[2];
#pragma unroll
            for (int i = 0; i < 2; ++i) { x0[i] = last ? n0[i] : c0[i]; x1[i] = last ? n1[i] : c1[i]; }
            PG8_LDB(B0, 0, 0); PG8_LDB(B1, 0, 1); PG8_SCHED; PG8_LDA(At, 0, 0); PG8_STAGE(PG8_SA(1, 1), a1, c1);
            PG8_WAIT_V(8); PG8_WAIT_L(0); PG8_BAR; PG8_MMA(0, 0, At, B0); PG8_MMA(0, 1, At, B1); PG8_BAR; PG8_SCHED;
            PG8_LDA(At, 0, 1); PG8_STAGE(PG8_SB(0, 0), b2, voffB); PG8_STAGE(PG8_SB(0, 1), b2 + hstep, voffB); PG8_STAGE(PG8_SA(0, 0), a2, x0);
            PG8_WAIT_V(8); PG8_WAIT_L(0); PG8_BAR; PG8_MMA(1, 0, At, B0); PG8_MMA(1, 1, At, B1); PG8_BAR; PG8_SCHED;
            PG8_LDB(B0, 1, 0); PG8_LDB(B1, 1, 1); PG8_SCHED; PG8_LDA(At, 1, 0); PG8_STAGE(PG8_SA(0, 1), a2, x1);
            PG8_WAIT_V(8); PG8_WAIT_L(0); PG8_BAR; PG8_MMA(0, 0, At, B0); PG8_MMA(0, 1, At, B1); PG8_BAR; PG8_SCHED;
            PG8_LDA(At, 1, 1); PG8_STAGE(PG8_SB(1, 0), b3, voffB); PG8_STAGE(PG8_SB(1, 1), b3 + hstep, voffB); PG8_STAGE(PG8_SA(1, 0), a3, x0);
            PG8_WAIT_V(8); PG8_WAIT_L(0); PG8_BAR; PG8_MMA(1, 0, At, B0); PG8_MMA(1, 1, At, B1); PG8_BAR; PG8_SCHED;
            if constexpr (Sched::DEFER) { if (t == 0 && pend) { S.done(pu, lane); pend = false; } }
        }
        if constexpr (Epi::FP8) asm volatile("s_nop 15\n\ts_nop 15" ::: "memory");
        if (wr == 0) PG8_BAR;
        E(acc, cur, wr, wc, fr, fq);
        if constexpr (Sched::DEFER) { pu = cur; pend = true; } else { S.done(cur, lane); }
        if (!has_next) break;
#pragma unroll
        for (int a = 0; a < 2; ++a)
#pragma unroll
            for (int b = 0; b < 2; ++b)
#pragma unroll
                for (int m = 0; m < 4; ++m)
#pragma unroll
                    for (int n = 0; n < 2; ++n) acc[a][b][m][n] = (f32x4){0.f, 0.f, 0.f, 0.f};
        cur = nxt; cB = nB; cA = nA; ++ui;
#pragma unroll
        for (int i = 0; i < 2; ++i) { c0[i] = n0[i]; c1[i] = n1[i]; }
        if (wr == 1) PG8_BAR;
    }
    PG8_WAIT_V(0);
    if constexpr (Sched::DEFER) { if (pend) S.done(pu, lane); }
    PG8_BAR;
#undef PG8_SA
#undef PG8_SB
#undef PG8_STAGE
#undef PG8_LDA
#undef PG8_LDB
#undef PG8_MMA
#undef PG8_WAIT_V
#undef PG8_WAIT_L
#undef PG8_BAR
#undef PG8_SCHED
#undef PG8_AOFFS
}
}

struct Args { const float* in[18]; float* out; unsigned char* ws; int ph_lo, ph_hi; };
typedef const float* const __attribute__((address_space(4)))* kin_t;
struct Frame {
    LAS unsigned char* lds;
    int tid, lane, wave, vcu, G, bid;
    unsigned char* ws; const Args* ap;
    __device__ __forceinline__ const float* in(int i) const { return ((kin_t)(uintptr_t)ap)[i]; }
    __device__ __forceinline__ float* out() const { return (float*)((kin_t)(uintptr_t)ap)[18]; }
    __device__ __forceinline__ unsigned* ctl() const { return (unsigned*)(ws + WS_CTL); }
    __device__ __forceinline__ float* MOD() const { return (float*)(ws + WS_MOD); }
    __device__ __forceinline__ float* ROPE() const { return (float*)(ws + WS_ROPE); }
    __device__ __forceinline__ float* AFF() const { return (float*)(ws + WS_AFF); }
    __device__ __forceinline__ float* GATE() const { return (float*)(ws + WS_GATE); }
    __device__ __forceinline__ float* X() const { return (float*)(ws + WS_X); }
    __device__ __forceinline__ float* X1() const { return (float*)(ws + WS_X1); }
    __device__ __forceinline__ float* U() const { return (float*)(ws + WS_U); }
    __device__ __forceinline__ int* ROWS() const { return (int*)(ws + WS_ROWS); }
    __device__ __forceinline__ short* INV() const { return (short*)(ws + WS_INV); }
    __device__ __forceinline__ bf16_t* H() const { return (bf16_t*)(ws + WS_H); }
    __device__ __forceinline__ bf16_t* PROJ() const { return (bf16_t*)(ws + WS_PROJ); }
    __device__ __forceinline__ bf16_t* MIX() const { return (bf16_t*)(ws + WS_MIX); }
    __device__ __forceinline__ bf16_t* ST() const { return (bf16_t*)(ws + WS_ST); }
    __device__ __forceinline__ bf16_t* ACT() const { return (bf16_t*)(ws + WS_ACT); }
    __device__ __forceinline__ bf16_t* YB() const { return (bf16_t*)(ws + WS_YB); }
    __device__ __forceinline__ bf16_t* WIN() const { return (bf16_t*)(ws + WS_WIN); }
    __device__ __forceinline__ bf16_t* WOUT() const { return (bf16_t*)(ws + WS_WOUT); }
    __device__ __forceinline__ bf16_t* WGU() const { return (bf16_t*)(ws + WS_WGU); }
    __device__ __forceinline__ bf16_t* WD() const { return (bf16_t*)(ws + WS_WD); }
};

constexpr int CW_C5 = 16384;
constexpr int CW_C8 = 65536;
__device__ __forceinline__ void wait_counter(unsigned* cnt, unsigned need, int tid) {
    if (tid < 64) {
        unsigned polls = 0;
        while ((unsigned)__builtin_amdgcn_readfirstlane(__hip_atomic_load(cnt, __ATOMIC_RELAXED, __HIP_MEMORY_SCOPE_AGENT)) < need) {
            __builtin_amdgcn_s_sleep(2);
            if (++polls > (1u << 22)) break;
        }
        __builtin_amdgcn_fence(__ATOMIC_ACQUIRE, "agent");
        asm volatile("s_waitcnt vmcnt(0)" ::: "memory");
    }
    asm volatile("" ::: "memory"); __builtin_amdgcn_s_barrier(); asm volatile("" ::: "memory");
}
__device__ __forceinline__ void arrive_counter(unsigned* cnt, int lane) {
    if (lane == 0) __hip_atomic_fetch_add(cnt, 1u, __ATOMIC_RELAXED, __HIP_MEMORY_SCOPE_AGENT);
}

struct SchedDense {
    static constexpr bool DEFER = false;
    int nM, nN, nwg, G, c; const char* A; const char* Bt; int K;
    __device__ __forceinline__ bool next(int i, pg8::Unit& u) const {
        const long L = (long)i * G + c; if (L >= nwg) return false;
        int wgid = (int)L; { const int q = nwg / 8, r = nwg % 8, xcd = wgid % 8, off = wgid / 8; wgid = (xcd < r ? xcd * (q + 1) : r * (q + 1) + (xcd - r) * q) + off; }
        const int nig = 8 * nN, gid = wgid / nig, fm = gid * 8, gsz = (nM - fm) < 8 ? (nM - fm) : 8;
        u.pm = fm + ((wgid % nig) % gsz); u.pn = (wgid % nig) / gsz; u.e = 0; u.t = 0; return true;
    }
    __device__ __forceinline__ int arow(const pg8::Unit& u, int r) const { return u.pm * 256 + r; }
    __device__ __forceinline__ const char* abase(const pg8::Unit&) const { return A; }
    __device__ __forceinline__ const char* bbase(const pg8::Unit& u) const { return Bt + (size_t)u.pn * 256 * K * 2; }
    __device__ __forceinline__ void a_ready(const pg8::Unit&, int) const {}
    __device__ __forceinline__ void done(const pg8::Unit&, int) const {}
};
struct SchedOut {
    static constexpr bool DEFER = false;
    int nwg, G, c; const char* A; const char* Bt; unsigned* cnt;
    __device__ __forceinline__ bool next(int i, pg8::Unit& u) const {
        const int L = i * G + c; if (L >= nwg) return false;
        if (L < 256) { const int wgid = (L % 8) * 32 + L / 8; u.pm = (wgid / 32) * 8 + (wgid % 32) % 8; u.pn = (wgid % 32) / 8; }
        else { const int j = L - 256; u.pm = 64 + j % 4; u.pn = j / 4; }
        u.e = 0; u.t = 0; return true;
    }
    __device__ __forceinline__ int arow(const pg8::Unit& u, int r) const { return u.pm * 256 + r; }
    __device__ __forceinline__ const char* abase(const pg8::Unit&) const { return A; }
    __device__ __forceinline__ const char* bbase(const pg8::Unit& u) const { return Bt + (size_t)u.pn * 256 * 1024 * 2; }
    __device__ __forceinline__ void a_ready(const pg8::Unit&, int) const {}
    __device__ __forceinline__ void done(const pg8::Unit& u, int lane) const { asm volatile("s_waitcnt vmcnt(0)" ::: "memory"); arrive_counter(cnt + 64 * u.pm, lane); }
};
struct SchedFfn {
    static constexpr bool DEFER = true;
    int nM, n8, n9, G, c; const char* Hb; const char* ACTb; const char* Wgu; const char* Wd; const LAS int* lrows; unsigned* cnt;
    __device__ __forceinline__ bool next(int i, pg8::Unit& u) const {
        const int L = i * G + c; if (L >= n8 + n9) return false;
        if (L < n8) { u.t = i << 8; const int wgid = (L % 8) * (n8 / 8) + L / 8; const int per = nM * 8; u.e = wgid / per; const int r = wgid % per; u.pn = r / nM; u.pm = r % nM; }
        else { u.t = 1 | (i << 8); const int j = L - n8, half = n9 / 2, eh = j / half, jj = j % half; const int wgid = (jj % 8) * (half / 8) + jj / 8; const int per = nM * 4;
               u.e = 2 * (wgid / per) + eh; const int r = wgid % per; u.pn = r / nM; u.pm = r % nM; }
        return true;
    }
    __device__ __forceinline__ int arow(const pg8::Unit& u, int r) const { return (u.t & 1) == 0 ? lrows[(u.t >> 8) * 256 + r] : u.e * EROWS + u.pm * 256 + r; }
    __device__ __forceinline__ const char* abase(const pg8::Unit& u) const { return (u.t & 1) == 0 ? Hb : ACTb; }
    __device__ __forceinline__ const char* bbase(const pg8::Unit& u) const {
        constexpr size_t ESZ = FFN_FP8 ? 1 : 2;
        return (u.t & 1) == 0 ? Wgu + (size_t)u.e * 2048 * 1024 * ESZ + (size_t)u.pn * 256 * 1024 * ESZ : Wd + (size_t)u.e * 1024 * 1024 * ESZ + (size_t)u.pn * 256 * 1024 * ESZ; }
    __device__ __forceinline__ void a_ready(const pg8::Unit& u, int tid) const { if (u.t & 1) wait_counter(cnt + 64 * (u.e * 9 + u.pm), 64u, tid); }
    __device__ __forceinline__ void done(const pg8::Unit& u, int lane) const { if ((u.t & 1) == 0) arrive_counter(cnt + 64 * (u.e * 9 + u.pm), lane); }
};

struct EpiIn {
    static constexpr bool PERM = true, FP8 = false;
    bf16_t* O; const LAS float* rope;
    __device__ __forceinline__ void operator()(const f32x4 (&acc)[2][2][4][2], const pg8::Unit& u, int wr, int wc, int fr, int fq) const {
        const bool latent = u.pm < 64;
        const bool lowhalf = fq < 2;
#pragma unroll
        for (int bj = 0; bj < 2; ++bj) {
            const int seg = 2 * u.pn + bj;
            const bool is_rope = latent && (seg == 6 || seg == 7 || seg == 8 || seg == 9 || (seg >= 16 && seg <= 20));
            const float sc = (seg == 8 || seg == 9 || (seg >= 16 && seg <= 19)) ? 0.125f : 1.0f;
            const int colb = u.pn * 256 + bj * 128 + wc * 32 + 8 * fq;
#pragma unroll
            for (int ai = 0; ai < 2; ++ai)
#pragma unroll
                for (int m = 0; m < 4; ++m) {
                    const int row = u.pm * 256 + ai * 128 + wr * 64 + m * 16 + fr;
                    f32x4 v0 = acc[ai][bj][m][0] * sc, v1 = acc[ai][bj][m][1] * sc;
                    if (is_rope) {
                        const int t = row & (SEQ - 1);
                        const int pos = (wc & 1) ? (t & 63) : (t >> 6);
                        const LAS float* cp = rope + pos * 16 + 8 * (fq & 1);
                        const f32x4 c0 = *(const LAS f32x4*)cp, c1 = *(const LAS f32x4*)(cp + 4);
                        f32x4 s0 = *(const LAS f32x4*)(cp + 1024), s1 = *(const LAS f32x4*)(cp + 1028);
                        if (lowhalf) { s0 = -s0; s1 = -s1; }
                        f32x4 o0, o1;
#pragma unroll
                        for (int i = 0; i < 4; ++i) {
                            { const auto rr = __builtin_amdgcn_permlane32_swap(__float_as_uint(v0[i]), __float_as_uint(v0[i]), false, false);
                              const float other = __uint_as_float(lowhalf ? rr[1] : rr[0]); o0[i] = v0[i] * c0[i] + other * s0[i]; }
                            { const auto rr = __builtin_amdgcn_permlane32_swap(__float_as_uint(v1[i]), __float_as_uint(v1[i]), false, false);
                              const float other = __uint_as_float(lowhalf ? rr[1] : rr[0]); o1[i] = v1[i] * c1[i] + other * s1[i]; }
                        }
                        v0 = o0; v1 = o1;
                    }
                    u32x4 w; w.x = pk2(v0[0], v0[1]); w.y = pk2(v0[2], v0[3]); w.z = pk2(v1[0], v1[1]); w.w = pk2(v1[2], v1[3]);
                    *(u32x4*)(O + (size_t)row * INW + colb) = w;
                }
        }
    }
};
struct EpiOut {
    static constexpr bool PERM = true, FP8 = false;
    bf16_t* Y1; const float* mod;
    __device__ __forceinline__ void operator()(const f32x4 (&acc)[2][2][4][2], const pg8::Unit& u, int wr, int wc, int fr, int fq) const {
        const int b = u.pm < 64 ? (u.pm >> 4) : 4;
        const float* g1 = mod + b * 6144 + 2048;
        const __amdgpu_buffer_rsrc_t rs = __builtin_amdgcn_make_buffer_rsrc((void*)Y1, (short)0, MROWS * D * 2, 0x00020000);
#pragma unroll
        for (int bj = 0; bj < 2; ++bj) {
            const int col = u.pn * 256 + bj * 128 + wc * 32 + 8 * fq;
            const f32x4 g0 = *(const f32x4*)(g1 + col), g1v = *(const f32x4*)(g1 + col + 4);
#pragma unroll
            for (int ai = 0; ai < 2; ++ai)
#pragma unroll
                for (int m = 0; m < 4; ++m) {
                    const int row = u.pm * 256 + ai * 128 + wr * 64 + m * 16 + fr;
                    const f32x4 r0 = g0 * acc[ai][bj][m][0], r1 = g1v * acc[ai][bj][m][1];
                    u32x4 w; w.x = pk2(r0[0], r0[1]); w.y = pk2(r0[2], r0[3]); w.z = pk2(r1[0], r1[1]); w.w = pk2(r1[2], r1[3]);
                    __builtin_amdgcn_raw_buffer_store_b128(w, rs, (unsigned)((row * D + col) * 2), 0, 16);
                }
        }
    }
};
__device__ __forceinline__ unsigned pk4_fp8(float a, float b, float c, float d) { unsigned w = 0u; w = __builtin_amdgcn_cvt_pk_fp8_f32(a, b, w, false); w = __builtin_amdgcn_cvt_pk_fp8_f32(c, d, w, true); return w; }
struct EpiFfn {
    static constexpr bool PERM = true, FP8 = (FFN_FP8 != 0);
    void* ACT; bf16_t* YB; const float* gate;
    __device__ __forceinline__ void operator()(const f32x4 (&acc)[2][2][4][2], const pg8::Unit& u, int wr, int wc, int fr, int fq) const {
        if ((u.t & 1) == 0) {
            constexpr float ASC = FP8 ? (1.0f / 32.0f) : 1.0f;
            constexpr float OSC = FP8 ? 8.0f : 1.0f;
            const __amdgpu_buffer_rsrc_t rs = __builtin_amdgcn_make_buffer_rsrc(ACT, (short)0, NE * EROWS * 1024 * (FP8 ? 1 : 2), 0x00020000);
#pragma unroll
            for (int ai = 0; ai < 2; ++ai)
#pragma unroll
                for (int m = 0; m < 4; ++m) {
                    const int row = u.e * EROWS + u.pm * 256 + ai * 128 + wr * 64 + m * 16 + fr;
                    float r[8];
#pragma unroll
                    for (int n = 0; n < 2; ++n)
#pragma unroll
                        for (int q = 0; q < 4; ++q) { const float a = acc[ai][0][m][n][q] * ASC; r[4 * n + q] = a * __builtin_amdgcn_rcpf(1.0f + fexp(-a)) * (acc[ai][1][m][n][q] * (ASC * OSC)); }
                    if constexpr (FP8) {
                        const unsigned long long w = (unsigned long long)pk4_fp8(r[0], r[1], r[2], r[3]) | ((unsigned long long)pk4_fp8(r[4], r[5], r[6], r[7]) << 32);
                        __hip_atomic_store((unsigned long long*)((unsigned char*)ACT + (size_t)row * 1024 + u.pn * 128 + wc * 32 + 8 * fq), w, __ATOMIC_RELAXED, __HIP_MEMORY_SCOPE_AGENT);
                    } else {
                        u32x4 w; w.x = pk2(r[0], r[1]); w.y = pk2(r[2], r[3]); w.z = pk2(r[4], r[5]); w.w = pk2(r[6], r[7]);
                        __builtin_amdgcn_raw_buffer_store_b128(w, rs, (unsigned)((row * 1024 + u.pn * 128 + wc * 32 + 8 * fq) * 2), 0, 16);
                    }
                }
        } else {
            constexpr float YSC = FP8 ? (64.0f / 256.0f) : 1.0f;
#pragma unroll
            for (int ai = 0; ai < 2; ++ai)
#pragma unroll
                for (int m = 0; m < 4; ++m) {
                    const int row = u.e * EROWS + u.pm * 256 + ai * 128 + wr * 64 + m * 16 + fr;
                    const float gt = gate[row] * YSC;
#pragma unroll
                    for (int bj = 0; bj < 2; ++bj) {
                        const f32x4 r0 = acc[ai][bj][m][0] * gt, r1 = acc[ai][bj][m][1] * gt;
                        if constexpr (FP8) {
                            u32x2 w; w.x = pk4_fp8(r0[0], r0[1], r0[2], r0[3]); w.y = pk4_fp8(r1[0], r1[1], r1[2], r1[3]);
                            *(u32x2*)((unsigned char*)YB + (size_t)row * 1024 + u.pn * 256 + bj * 128 + wc * 32 + 8 * fq) = w;
                        } else {
                            u32x4 w; w.x = pk2(r0[0], r0[1]); w.y = pk2(r0[2], r0[3]); w.z = pk2(r1[0], r1[1]); w.w = pk2(r1[2], r1[3]);
                            *(u32x4*)(YB + (size_t)row * 1024 + u.pn * 256 + bj * 128 + wc * 32 + 8 * fq) = w;
                        }
                    }
                }
        }
    }
};

__device__ __forceinline__ void p0_transpose_item(const float* W, int N, bf16_t* WT, int out_row0, LAS unsigned* scr, int kb, int n0, int lane) {
    const int k0 = 64 * kb;
    const float* wp = W + (size_t)k0 * N + n0 + lane;
#pragma unroll
    for (int g = 0; g < 2; ++g) {
        float t[32];
#pragma unroll
        for (int i = 0; i < 32; ++i) t[i] = __builtin_nontemporal_load(wp + (size_t)(32 * g + i) * N);
#pragma unroll
        for (int i = 0; i < 16; ++i) scr[(16 * g + i) * 65 + lane] = pk2(t[2 * i], t[2 * i + 1]);
    }
    LDS_WAIT(); asm volatile("" ::: "memory");
    const int c = lane & 7;
#pragma unroll
    for (int j = 0; j < 8; ++j) { const int n = (lane >> 3) + 8 * j; const LAS unsigned* sp = scr + (4 * c) * 65 + n;
        u32x4 o; o.x = sp[0]; o.y = sp[65]; o.z = sp[130]; o.w = sp[195];
        __builtin_nontemporal_store(o, (u32x4*)(WT + (size_t)(out_row0 + n) * 1024 + k0 + 8 * c)); }
    LDS_WAIT(); asm volatile("" ::: "memory");
}
#if FFN_FP8
__device__ __forceinline__ void p0_transpose_item8(const float* W, int N, unsigned char* WT, int out_row0, LAS unsigned* scr, int kb, int n0, int lane) {
    const int k0 = 64 * kb;
    const float* wp = W + (size_t)k0 * N + n0 + lane;
#pragma unroll
    for (int g = 0; g < 2; ++g) {
        float t[32];
#pragma unroll
        for (int i = 0; i < 32; ++i) t[i] = __builtin_nontemporal_load(wp + (size_t)(32 * g + i) * N) * 32.0f;
#pragma unroll
        for (int i = 0; i < 8; ++i) scr[(8 * g + i) * 65 + lane] = pk4_fp8(t[4 * i], t[4 * i + 1], t[4 * i + 2], t[4 * i + 3]);
    }
    LDS_WAIT(); asm volatile("" ::: "memory");
    const int c = lane & 3;
#pragma unroll
    for (int j = 0; j < 4; ++j) { const int n = (lane >> 2) + 16 * j; const LAS unsigned* sp = scr + (4 * c) * 65 + n;
        u32x4 o; o.x = sp[0]; o.y = sp[65]; o.z = sp[130]; o.w = sp[195];
        __builtin_nontemporal_store(o, (u32x4*)(WT + (size_t)(out_row0 + n) * 1024 + k0 + 16 * c)); }
    LDS_WAIT(); asm volatile("" ::: "memory");
}
#endif
constexpr int CV_IN = 16 * (INW / 64), CV_SQ = 16 * 16, CV_LAYER = CV_IN + CV_SQ + NE * 3 * CV_SQ;
__device__ __forceinline__ void convert_item(Frame& F, int l, int it, LAS unsigned* scr) {
    int r = it;
    if (r < CV_IN) { const int kb = r / (INW / 64), nb = r % (INW / 64);
        p0_transpose_item(F.in(8) + (size_t)l * 1024 * INW, INW, F.WIN() + (size_t)l * INW * 1024, 64 * nb, scr, kb, 64 * nb, F.lane); return; }
    r -= CV_IN;
    if (r < CV_SQ) { const int kb = r / 16, nb = r % 16;
        p0_transpose_item(F.in(12) + (size_t)l * 1024 * 1024, 1024, F.WOUT() + (size_t)l * 1024 * 1024, 64 * nb, scr, kb, 64 * nb, F.lane); return; }
    r -= CV_SQ;
    const int mat = r / CV_SQ; r %= CV_SQ; const int kb = r / 16, nb = r % 16; const int which = mat % 3, le = l * NE + mat / 3;
#if FFN_FP8
    unsigned char* wgu8 = (unsigned char*)F.WGU() + (size_t)le * 2048 * 1024; unsigned char* wd8 = (unsigned char*)F.WD() + (size_t)le * 1024 * 1024;
    if (which == 0) p0_transpose_item8(F.in(14) + (size_t)le * 1024 * 1024, 1024, wgu8, (nb >> 1) * 256 + (nb & 1) * 64, scr, kb, 64 * nb, F.lane);
    else if (which == 1) p0_transpose_item8(F.in(15) + (size_t)le * 1024 * 1024, 1024, wgu8, (nb >> 1) * 256 + 128 + (nb & 1) * 64, scr, kb, 64 * nb, F.lane);
    else p0_transpose_item8(F.in(16) + (size_t)le * 1024 * 1024, 1024, wd8, 64 * nb, scr, kb, 64 * nb, F.lane);
#else
    if (which == 0) p0_transpose_item(F.in(14) + (size_t)le * 1024 * 1024, 1024, F.WGU() + (size_t)le * 2048 * 1024, (nb >> 1) * 256 + (nb & 1) * 64, scr, kb, 64 * nb, F.lane);
    else if (which == 1) p0_transpose_item(F.in(15) + (size_t)le * 1024 * 1024, 1024, F.WGU() + (size_t)le * 2048 * 1024, (nb >> 1) * 256 + 128 + (nb & 1) * 64, scr, kb, 64 * nb, F.lane);
    else p0_transpose_item(F.in(16) + (size_t)le * 1024 * 1024, 1024, F.WD() + (size_t)le * 1024 * 1024, 64 * nb, scr, kb, 64 * nb, F.lane);
#endif
}
__device__ __forceinline__ void p0_prologue(Frame& F) {
    LAS unsigned* scr = (LAS unsigned*)(F.lds + F.wave * 16384);
    const int gw = F.vcu * NWAVES + F.wave, NGW = F.G * NWAVES;
    for (int it = gw; it < DEPTH * CV_LAYER; it += NGW) convert_item(F, it / CV_LAYER, it % CV_LAYER, scr);
    __syncthreads();
    LAS float* sS = (LAS float*)F.lds;
    LAS float* red = (LAS float*)(F.lds + 32768);
    for (int i = F.tid; i < 5 * 1024; i += NTHREADS) { const float v = i < 4096 ? F.in(1)[i] : F.in(3)[i - 4096]; sS[i] = silu_f(v); }
    __syncthreads();
    for (int item = F.bid; item < DEPTH * 96; item += F.G) {
        const int l = item / 96, jg = item % 96, j = jg * 64 + F.lane;
        const float* wp = F.in(4) + ((size_t)l * 1024 + F.wave * 128) * 6144 + j;
        float a0 = 0.f, a1 = 0.f, a2 = 0.f, a3 = 0.f, a4 = 0.f;
#pragma unroll 8
        for (int kk = 0; kk < 128; ++kk) { const float w = __builtin_nontemporal_load(wp + (size_t)kk * 6144); const int k = F.wave * 128 + kk;
            a0 += sS[k] * w; a1 += sS[1024 + k] * w; a2 += sS[2048 + k] * w; a3 += sS[3072 + k] * w; a4 += sS[4096 + k] * w; }
        red[(F.wave * 5 + 0) * 64 + F.lane] = a0; red[(F.wave * 5 + 1) * 64 + F.lane] = a1; red[(F.wave * 5 + 2) * 64 + F.lane] = a2;
        red[(F.wave * 5 + 3) * 64 + F.lane] = a3; red[(F.wave * 5 + 4) * 64 + F.lane] = a4;
        __syncthreads();
        if (F.tid < 320) { const int b = F.tid >> 6, ln = F.tid & 63; float s = F.in(5)[l * 6144 + jg * 64 + ln];
#pragma unroll
            for (int w = 0; w < 8; ++w) s += red[(w * 5 + b) * 64 + ln];
            F.MOD()[(size_t)(l * 5 + b) * 6144 + jg * 64 + ln] = s; }
        __syncthreads();
    }
    if (F.bid == F.G - 1) {
        for (int i = F.tid; i < 1024; i += NTHREADS) {
            const int pos = i >> 4, f = i & 15;
            const float invf = exp2f(-(float)f * (13.287712379549449f / 16.0f));
            const float angf = (float)pos * invf;
            double a = (double)angf; const double TWO_PI = 6.283185307179586476925;
            a -= TWO_PI * rint(a / TWO_PI);
            const double a2 = a * a; double cs = 1.0, sn = a, tc = 1.0, ts = a;
#pragma unroll 1
            for (int n = 1; n <= 12; ++n) { tc *= -a2 / (double)((2 * n - 1) * (2 * n)); ts *= -a2 / (double)((2 * n) * (2 * n + 1)); cs += tc; sn += ts; }
            F.ROPE()[i] = (float)cs; F.ROPE()[1024 + i] = (float)sn;
        }
    }
}

__device__ __forceinline__ f32x4 y1_quarter(const bf16_t* y1row, int lane, int j) { const u32x2 q = *(const u32x2*)(y1row + 4 * lane + 256 * j); return (f32x4){bflo(q.x), bfhi(q.x), bflo(q.y), bfhi(q.y)}; }
__device__ __forceinline__ const float* xsrc_row(const Frame& F, bool from_inputs, int row) {
    return from_inputs ? (row < NLAT ? F.in(0) + (size_t)row * D : F.in(2) + (size_t)(row - NLAT) * D) : F.X() + (size_t)row * D; }
__device__ __forceinline__ bf16_t* Y1buf(const Frame& F) { return (bf16_t*)(F.ws + WS_X1); }
__device__ __forceinline__ bf16_t* XBbuf(const Frame& F) { return (bf16_t*)(F.ws + WS_X); }
template <bool XIN> __device__ __forceinline__ const char* xrow_ptr(const Frame& F, int row) {
    if constexpr (XIN) return (const char*)xsrc_row(F, true, row); else return (const char*)(XBbuf(F) + (size_t)row * D); }
template <bool XIN> __device__ __forceinline__ f32x4 xrow_q(const char* p, int lane, int j) {
    if constexpr (XIN) return ((const f32x4*)p)[lane + 64 * j]; else return y1_quarter((const bf16_t*)p, lane, j); }
__device__ __forceinline__ void p1_one(Frame& F, int l, bool fin, int row, f32x4 (&v)[4], const u32x4 i0, const u32x4 i1, const f32x4 (&gm)[4], const f32x4 (&sh)[4], const f32x4 (&g2)[4]) {
    const int lane = F.lane;
    if (l > 0) {
        f32x4 ys[4];
#pragma unroll
        for (int j = 0; j < 4; ++j) ys[j] = (f32x4){0.f, 0.f, 0.f, 0.f};
#pragma unroll
        for (int e = 0; e < 16; ++e) {
            const unsigned w = (e < 8) ? i0[(e & 7) >> 1] : i1[(e & 7) >> 1];
            const int p = __builtin_amdgcn_readfirstlane((int)(short)((e & 1) ? (w >> 16) : (w & 0xffffu)));
            if (p >= 0) {
#if FFN_FP8
                const unsigned char* yr = (const unsigned char*)F.YB() + (size_t)(e * EROWS + p) * 1024;
#pragma unroll
                for (int j = 0; j < 4; ++j) { const unsigned q = __builtin_nontemporal_load((const unsigned*)(yr + 4 * lane + 256 * j));
                    ys[j][0] += __builtin_amdgcn_cvt_f32_fp8(q, 0); ys[j][1] += __builtin_amdgcn_cvt_f32_fp8(q, 1); ys[j][2] += __builtin_amdgcn_cvt_f32_fp8(q, 2); ys[j][3] += __builtin_amdgcn_cvt_f32_fp8(q, 3); }
#else
                const bf16_t* yr = F.YB() + (size_t)(e * EROWS + p) * 1024;
#pragma unroll
                for (int j = 0; j < 4; ++j) { const u32x2 q = *(const u32x2*)(yr + 4 * lane + 256 * j);
                    ys[j][0] += bflo(q.x); ys[j][1] += bfhi(q.x); ys[j][2] += bflo(q.y); ys[j][3] += bfhi(q.y); }
#endif
            }
        }
#pragma unroll
        for (int j = 0; j < 4; ++j) v[j] = v[j] + g2[j] * ys[j] * (FFN_FP8 ? (1.0f / 64.0f) : 1.0f);
    }
    if (!fin && l > 0) {
#pragma unroll
        for (int j = 0; j < 4; ++j) { u32x2 w; w.x = pk2(v[j][0], v[j][1]); w.y = pk2(v[j][2], v[j][3]); *(u32x2*)(XBbuf(F) + (size_t)row * D + 4 * lane + 256 * j) = w; }
    }
    float ss = 0.f;
#pragma unroll
    for (int j = 0; j < 4; ++j) ss += (v[j][0] * v[j][0] + v[j][1] * v[j][1]) + (v[j][2] * v[j][2] + v[j][3] * v[j][3]);
    const float rstd = 1.0f / sqrtf(wave_sum(ss, lane) * (1.0f / D) + EPS);
    if (fin) {
#pragma unroll
        for (int j = 0; j < 4; ++j) __builtin_nontemporal_store(v[j] * rstd * gm[j], (f32x4*)(F.out() + (size_t)row * D) + lane + 64 * j);
    } else {
#pragma unroll
        for (int j = 0; j < 4; ++j) {
            const f32x4 h = v[j] * rstd * gm[j] + sh[j];
            u32x2 w; w.x = pk2(h[0], h[1]); w.y = pk2(h[2], h[3]);
            *(u32x2*)(F.H() + (size_t)row * D + 4 * lane + 256 * j) = w;
        }
    }
}
__device__ __forceinline__ void p1_mod(Frame& F, int l, bool fin, int b, f32x4 (&gm)[4], f32x4 (&sh)[4], f32x4 (&g2)[4]) {
    const int lane = F.lane;
#pragma unroll
    for (int j = 0; j < 4; ++j) {
        if (fin) { gm[j] = ((const f32x4*)F.in(17))[lane + 64 * j]; sh[j] = (f32x4){0.f, 0.f, 0.f, 0.f}; }
        else { const float* md = F.MOD() + (size_t)(l * 5 + b) * 6144;
            const f32x4 g = ((const f32x4*)(F.in(6) + l * D))[lane + 64 * j], sc = ((const f32x4*)(md + 1024))[lane + 64 * j];
            gm[j] = g * (sc + 1.0f); sh[j] = ((const f32x4*)md)[lane + 64 * j]; }
        if (l > 0) g2[j] = ((const f32x4*)(F.MOD() + (size_t)((l - 1) * 5 + b) * 6144 + 5 * 1024))[lane + 64 * j];
        else g2[j] = (f32x4){0.f, 0.f, 0.f, 0.f};
    }
}
template <bool XIN>
__device__ __forceinline__ void p1_rows(Frame& F, int l) {
    const bool fin = (l == DEPTH);
    const int lane = F.lane;
    const int gw = F.vcu * NWAVES + F.wave;
    f32x4 gm[4], sh[4], g2[4];
    {
        const int r0 = gw * 8, b = r0 >> 12;
        p1_mod(F, l, fin, b, gm, sh, g2);
        f32x4 v[4], vn[4], yn[4]; u32x4 i0 = (u32x4){0u, 0u, 0u, 0u}, i1 = i0, i0n = i0, i1n = i0;
#pragma unroll
        for (int j = 0; j < 4; ++j) { v[j] = xrow_q<XIN>(xrow_ptr<XIN>(F, r0), lane, j); if (l > 0) v[j] = v[j] + y1_quarter(Y1buf(F) + (size_t)r0 * D, lane, j); }
        if (l > 0) { i0 = *(const u32x4*)(F.INV() + (size_t)r0 * 16); i1 = *(const u32x4*)(F.INV() + (size_t)r0 * 16 + 8); }
#pragma unroll 1
        for (int i = 0; i < 8; ++i) {
            const int row = r0 + i;
            if (i < 7) {
#pragma unroll
                for (int j = 0; j < 4; ++j) { vn[j] = xrow_q<XIN>(xrow_ptr<XIN>(F, row + 1), lane, j); yn[j] = (l > 0) ? y1_quarter(Y1buf(F) + (size_t)(row + 1) * D, lane, j) : (f32x4){0.f, 0.f, 0.f, 0.f}; }
                if (l > 0) { i0n = *(const u32x4*)(F.INV() + (size_t)(row + 1) * 16); i1n = *(const u32x4*)(F.INV() + (size_t)(row + 1) * 16 + 8); }
            }
            p1_one(F, l, fin, row, v, i0, i1, gm, sh, g2);
#pragma unroll
            for (int j = 0; j < 4; ++j) v[j] = vn[j] + yn[j];
            i0 = i0n; i1 = i1n;
        }
    }
    if (!fin && (F.wave & 1) == 0) {
        const int row = NLAT + F.vcu * 4 + (F.wave >> 1);
        p1_mod(F, l, fin, 4, gm, sh, g2);
        f32x4 v[4]; u32x4 i0 = (u32x4){0u, 0u, 0u, 0u}, i1 = i0;
#pragma unroll
        for (int j = 0; j < 4; ++j) { v[j] = xrow_q<XIN>(xrow_ptr<XIN>(F, row), lane, j); if (l > 0) v[j] = v[j] + y1_quarter(Y1buf(F) + (size_t)row * D, lane, j); }
        if (l > 0) { i0 = *(const u32x4*)(F.INV() + (size_t)row * 16); i1 = *(const u32x4*)(F.INV() + (size_t)row * 16 + 8); }
        p1_one(F, l, fin, row, v, i0, i1, gm, sh, g2);
    }
}

template <int NR, bool XIN>
__device__ __forceinline__ void p6_group(Frame& F, int l, int row0, int b, LAS float* wl) {
    const int lane = F.lane;
    const char* xr = xrow_ptr<XIN>(F, row0);
    constexpr size_t XRB = XIN ? (size_t)D * 4 : (size_t)D * 2;
    const bf16_t* yr = Y1buf(F) + (size_t)row0 * D;
    float rstd[NR];
    {
        f32x4 v[NR][4];
#pragma unroll
        for (int r = 0; r < NR; ++r)
#pragma unroll
            for (int j = 0; j < 4; ++j) v[r][j] = xrow_q<XIN>(xr + (size_t)r * XRB, lane, j) + y1_quarter(yr + (size_t)r * D, lane, j);
#pragma unroll
        for (int r = 0; r < NR; ++r) {
            float ss = 0.f;
#pragma unroll
            for (int j = 0; j < 4; ++j) ss += (v[r][j][0] * v[r][j][0] + v[r][j][1] * v[r][j][1]) + (v[r][j][2] * v[r][j][2] + v[r][j][3] * v[r][j][3]);
            rstd[r] = 1.0f / sqrtf(wave_sum(ss, lane) * (1.0f / D) + EPS);
        }
    }
    float acc[NR][16];
#pragma unroll
    for (int r = 0; r < NR; ++r)
#pragma unroll
        for (int e = 0; e < 16; ++e) acc[r][e] = 0.f;
    const float* md = F.MOD() + (size_t)(l * 5 + b) * 6144;
    const float* g2w = F.in(7) + l * D;
    f32x4 cg, csc, csh, cx[NR]; u32x2 cy[NR];
#define P6_LOADQ(j_, g_, sc_, sh_, x_, y_) do { g_ = ((const f32x4*)g2w)[lane + 64 * (j_)]; sc_ = ((const f32x4*)(md + 4096))[lane + 64 * (j_)]; sh_ = ((const f32x4*)(md + 3072))[lane + 64 * (j_)]; \
        _Pragma("unroll") for (int r_ = 0; r_ < NR; ++r_) { x_[r_] = xrow_q<XIN>(xr + (size_t)r_ * XRB, lane, (j_)); y_[r_] = *(const u32x2*)(yr + (size_t)r_ * D + 4 * lane + 256 * (j_)); } } while (0)
    P6_LOADQ(0, cg, csc, csh, cx, cy);
#pragma unroll 1
    for (int j = 0; j < 4; ++j) {
        f32x4 ng = cg, nsc = csc, nsh = csh, nx[NR]; u32x2 ny[NR];
#pragma unroll
        for (int r = 0; r < NR; ++r) { nx[r] = cx[r]; ny[r] = cy[r]; }
        if (j < 3) P6_LOADQ(j + 1, ng, nsc, nsh, nx, ny);
        const f32x4 gmv = cg * (csc + 1.0f), shv = csh;
        f32x4 h[NR];
#pragma unroll
        for (int r = 0; r < NR; ++r) {
            const f32x4 vq = cx[r] + (f32x4){bflo(cy[r].x), bfhi(cy[r].x), bflo(cy[r].y), bfhi(cy[r].y)};
            h[r] = vq * rstd[r] * gmv + shv;
#if FFN_FP8
            *(unsigned*)((unsigned char*)F.H() + (size_t)(row0 + r) * D + 4 * lane + 256 * j) = pk4_fp8(h[r][0], h[r][1], h[r][2], h[r][3]);
#else
            u32x2 w; w.x = pk2(h[r][0], h[r][1]); w.y = pk2(h[r][2], h[r][3]);
            *(u32x2*)(F.H() + (size_t)(row0 + r) * D + 4 * lane + 256 * j) = w;
#endif
        }
#pragma unroll
        for (int i = 0; i < 4; ++i) {
            const LAS f32x4* wp = (const LAS f32x4*)(wl + ((j * 4 + i) * 64 + lane) * 16);
            const f32x4 w0 = wp[0], w1 = wp[1], w2 = wp[2], w3 = wp[3];
#pragma unroll
            for (int r = 0; r < NR; ++r) { const float hv = h[r][i];
                acc[r][0] += hv * w0[0]; acc[r][1] += hv * w0[1]; acc[r][2] += hv * w0[2]; acc[r][3] += hv * w0[3];
                acc[r][4] += hv * w1[0]; acc[r][5] += hv * w1[1]; acc[r][6] += hv * w1[2]; acc[r][7] += hv * w1[3];
                acc[r][8] += hv * w2[0]; acc[r][9] += hv * w2[1]; acc[r][10] += hv * w2[2]; acc[r][11] += hv * w2[3];
                acc[r][12] += hv * w3[0]; acc[r][13] += hv * w3[1]; acc[r][14] += hv * w3[2]; acc[r][15] += hv * w3[3]; }
        }
        cg = ng; csc = nsc; csh = nsh;
#pragma unroll
        for (int r = 0; r < NR; ++r) { cx[r] = nx[r]; cy[r] = ny[r]; }
    }
#undef P6_LOADQ
    const int e = ((lane >> 5) & 1) * 8 + ((lane >> 4) & 1) * 4 + ((lane >> 3) & 1) * 2 + ((lane >> 2) & 1);
#pragma unroll
    for (int r = 0; r < NR; ++r) {
        float r8[8], r4[4], r2[2], r1;
        { const bool hi = (lane & 32) != 0;
#pragma unroll
          for (int i = 0; i < 8; ++i) { const float keep = hi ? acc[r][i + 8] : acc[r][i], send = hi ? acc[r][i] : acc[r][i + 8]; r8[i] = keep + shx(send, 32, lane); } }
        { const bool hi = (lane & 16) != 0;
#pragma unroll
          for (int i = 0; i < 4; ++i) { const float keep = hi ? r8[i + 4] : r8[i], send = hi ? r8[i] : r8[i + 4]; r4[i] = keep + shx(send, 16, lane); } }
        { const bool hi = (lane & 8) != 0;
#pragma unroll
          for (int i = 0; i < 2; ++i) { const float keep = hi ? r4[i + 2] : r4[i], send = hi ? r4[i] : r4[i + 2]; r2[i] = keep + shx(send, 8, lane); } }
        { const bool hi = (lane & 4) != 0; const float keep = hi ? r2[1] : r2[0], send = hi ? r2[0] : r2[1]; r1 = keep + shx(send, 4, lane); }
        r1 += shx(r1, 2, lane); r1 += shx(r1, 1, lane);
        float mx = r1;
        mx = fmaxf(mx, shx(mx, 4, lane)); mx = fmaxf(mx, shx(mx, 8, lane)); mx = max_x16(mx); mx = max_x32(mx);
        const float ex = __expf(r1 - mx);
        float sm = ex;
        sm += shx(sm, 4, lane); sm += shx(sm, 8, lane); sm = sum_x16(sm); sm = sum_x32(sm);
        const float aff = ex / sm;
        const int row = row0 + r;
        if ((lane & 3) == 0) {
            if (row < NLAT) F.AFF()[(size_t)(b * NE + e) * SEQ + (row & (SEQ - 1))] = aff;
            else { const int rc = row - NLAT; F.AFF()[(size_t)BATCH * NE * SEQ + (size_t)((rc >> 8) * NE + e) * CTXL + (rc & 255)] = aff; }
        }
    }
}
template <bool XIN>
__device__ __forceinline__ void p6_rows(Frame& F0, int l, unsigned* cnt5) {
    Frame F = F0; asm volatile("" : "+v"(F.lane), "+v"(F.tid), "+s"(F.vcu), "+s"(F.wave));
    LAS float* wl = (LAS float*)F.lds;
    {
        const f32x4* wsrc = (const f32x4*)(F.in(13) + (size_t)l * 1024 * 16);
        f32x4 t[8];
#pragma unroll
        for (int i = 0; i < 8; ++i) t[i] = wsrc[F.tid + NTHREADS * i];
#pragma unroll
        for (int i = 0; i < 8; ++i) { const int c = F.tid + NTHREADS * i, k = c >> 2, e0 = (c & 3) * 4;
            *(LAS f32x4*)(wl + (((k >> 8) * 4 + (k & 3)) * 64 + ((k >> 2) & 63)) * 16 + e0) = t[i]; }
    }
    __syncthreads();
    const int gw = F.vcu * NWAVES + F.wave;
    {
        const int r0 = gw * 8, b = r0 >> 12;
        wait_counter(cnt5 + 64 * (F.vcu >> 2), 32u, F.tid);
#pragma unroll 1
        for (int gi = 0; gi < 2; ++gi) p6_group<4, XIN>(F, l, r0 + 4 * gi, b, wl);
    }
    if (l != DEPTH - 1) {
        wait_counter(cnt5 + 64 * (64 + (F.vcu >> 2)), 32u, F.tid);
        if ((F.wave & 1) == 0) p6_group<1, XIN>(F, l, NLAT + F.vcu * 4 + (F.wave >> 1), 4, wl);
    }
}

__device__ __forceinline__ void p5_ctx_piece(Frame& F, int l, unsigned* cnt5) {
    const int lane = F.lane, fr = lane & 15, fq = lane >> 4;
    const int g = F.vcu >> 2, cq = F.vcu & 3;
    const int row0 = NLAT + 16 * g;
    const int n0 = 256 * cq + 32 * F.wave;
    const bf16_t* ap = F.MIX() + (size_t)(row0 + fr) * D + 8 * fq;
    const bf16_t* bp = F.WOUT() + (size_t)l * 1024 * 1024 + (size_t)(n0 + fr) * 1024 + 8 * fq;
    f32x4 acc0 = (f32x4){0.f, 0.f, 0.f, 0.f}, acc1 = acc0;
#pragma unroll 1
    for (int s0 = 0; s0 < 32; s0 += 8) {
        bf16x8 a[8], b0[8], b1[8];
#pragma unroll
        for (int k = 0; k < 8; ++k) { a[k] = *(const bf16x8*)(ap + 32 * (s0 + k)); b0[k] = *(const bf16x8*)(bp + 32 * (s0 + k)); b1[k] = *(const bf16x8*)(bp + 16 * 1024 + 32 * (s0 + k)); }
#pragma unroll
        for (int k = 0; k < 8; ++k) { acc0 = __builtin_amdgcn_mfma_f32_16x16x32_bf16(a[k], b0[k], acc0, 0, 0, 0); acc1 = __builtin_amdgcn_mfma_f32_16x16x32_bf16(a[k], b1[k], acc1, 0, 0, 0); }
    }
    const float* g1 = F.MOD() + (size_t)(l * 5 + 4) * 6144 + 2048;
    bf16_t* yo = Y1buf(F) + (size_t)row0 * D;
#pragma unroll
    for (int t = 0; t < 2; ++t) {
        const int col = n0 + 16 * t + fr; const float gg = g1[col];
#pragma unroll
        for (int r = 0; r < 4; ++r) { const int rr = 4 * fq + r; const float v = gg * (t == 0 ? acc0[r] : acc1[r]);
            __hip_atomic_store(yo + (size_t)rr * D + col, (bf16_t)(pk2(v, 0.f) & 0xffffu), __ATOMIC_RELAXED, __HIP_MEMORY_SCOPE_AGENT); }
    }
    asm volatile("s_waitcnt vmcnt(0)" ::: "memory");
    arrive_counter(cnt5 + 64 * (64 + g), lane);
}

__device__ __forceinline__ int wave_isum(int v, int lane) {
    v += shxi(v, 1, lane); v += shxi(v, 2, lane); v += shxi(v, 4, lane); v += shxi(v, 8, lane); v += shxi(v, 16, lane); v += shxi(v, 32, lane);
    return v;
}
__device__ __forceinline__ void p7_topk(Frame& F, int l) {
    LAS int* cnts = (LAS int*)F.lds;
    const int nprob = (l == DEPTH - 1) ? 64 : 128;
    const int tid = F.tid, lane = F.lane, wave = F.wave;
    for (int prob = F.bid; prob < nprob; prob += F.G) {
        const bool isc = prob >= 64; const int pb = prob & 63; const int b = pb >> 4, e = pb & 15;
        const int n = isc ? CTXL : SEQ, KSEL = isc ? CAP_C : CAP_L;
        const float* aff = isc ? F.AFF() + (size_t)BATCH * NE * SEQ + (size_t)(b * NE + e) * CTXL : F.AFF() + (size_t)(b * NE + e) * SEQ;
        unsigned key[8];
        if (tid * 8 < n) { const u32x4 k0 = *(const u32x4*)(aff + tid * 8), k1 = *(const u32x4*)(aff + tid * 8 + 4);
            key[0] = k0.x; key[1] = k0.y; key[2] = k0.z; key[3] = k0.w; key[4] = k1.x; key[5] = k1.y; key[6] = k1.z; key[7] = k1.w; }
        else {
#pragma unroll
            for (int i = 0; i < 8; ++i) key[i] = 0u;
        }
        unsigned prefix = 0u; int krem = KSEL;
        LAS int* hist = (LAS int*)(F.lds + 1024);
        LAS int* wtot = (LAS int*)(F.lds + 512);
#pragma unroll 1
        for (int pass = 0; pass < 3; ++pass) {
            const int shift = pass == 0 ? 19 : (pass == 1 ? 7 : 0), nbits = pass == 2 ? 7 : 12, hshift = shift + nbits;
            const int nb = 1 << nbits;
#pragma unroll
            for (int i = 0; i < 8; ++i) hist[tid * 8 + i] = 0;
            __syncthreads();
#pragma unroll
            for (int i = 0; i < 8; ++i) { const unsigned k = key[i]; if (k != 0u && (k >> hshift) == prefix) __hip_atomic_fetch_add(hist + ((k >> shift) & (unsigned)(nb - 1)), 1, __ATOMIC_RELAXED, __HIP_MEMORY_SCOPE_WORKGROUP); }
            __syncthreads();
            int hb[8]; int ssum = 0;
#pragma unroll
            for (int i = 0; i < 8; ++i) { hb[i] = hist[tid * 8 + i]; ssum += hb[i]; }
            int suf = ssum;
#pragma unroll
            for (int o = 1; o < 64; o <<= 1) { const int t = __builtin_amdgcn_ds_bpermute(((lane + o) & 63) << 2, suf); if (lane + o < 64) suf += t; }
            if (lane == 0) wtot[wave] = suf;
            __syncthreads();
            int above_w = 0;
#pragma unroll
            for (int w = 0; w < 8; ++w) { const int t = wtot[w]; if (w > wave) above_w += t; }
            const int incl = above_w + suf, excl = incl - ssum;
            if (excl < krem && krem <= incl) {
                int run = excl, dig = 0, cab = 0;
#pragma unroll
                for (int i = 7; i >= 0; --i) { if (run < krem && krem <= run + hb[i]) { dig = tid * 8 + i; cab = run; } run += hb[i]; }
                wtot[8] = dig; wtot[9] = cab;
            }
            __syncthreads();
            prefix = (prefix << nbits) | (unsigned)wtot[8]; krem -= wtot[9];
        }
        const unsigned T = prefix;
        int g = 0, q = 0;
#pragma unroll
        for (int i = 0; i < 8; ++i) { g += (key[i] > T) ? 1 : 0; q += (key[i] == T) ? 1 : 0; }
        int pack = g | (q << 16), incl = pack;
#pragma unroll
        for (int o = 1; o < 64; o <<= 1) { const int t = __builtin_amdgcn_ds_bpermute(((lane - o) & 63) << 2, incl); if (lane >= o) incl += t; }
        if (lane == 63) cnts[16 + wave] = incl;
        __syncthreads();
        int wpre = 0, total = 0;
#pragma unroll
        for (int w = 0; w < 8; ++w) { const int t = cnts[16 + w]; total += t; if (w < wave) wpre += t; }
        const int excl = wpre + incl - pack;
        int g_run = excl & 0xffff, q_run = excl >> 16;
        const int need = KSEL - (total & 0xffff);
        const int posbase = isc ? (4 * CAP_L + b * CAP_C) : b * CAP_L;
        const int rowbase = isc ? NLAT + b * CTXL : b * SEQ;
        if (tid * 8 < n) {
#pragma unroll
            for (int i = 0; i < 8; ++i) {
                const int token = tid * 8 + i; int slot = -1;
                if (key[i] > T) { slot = g_run + (q_run < need ? q_run : need); ++g_run; }
                else if (key[i] == T) { if (q_run < need) slot = g_run + q_run; ++q_run; }
                F.INV()[(size_t)(rowbase + token) * 16 + e] = (short)(slot >= 0 ? posbase + slot : -1);
                if (slot >= 0) { F.ROWS()[e * EROWS + posbase + slot] = rowbase + token; F.GATE()[e * EROWS + posbase + slot] = __uint_as_float(key[i]); }
            }
        }
        if (!isc && b == 0 && tid < 128) { F.ROWS()[e * EROWS + 2176 + tid] = 0; F.GATE()[e * EROWS + 2176 + tid] = 0.f; }
        __syncthreads();
    }
}

__device__ __forceinline__ float log_gamma(const Frame& F, int l, int dir, int h) {
    const float x = F.in(10)[(l * 2 + dir) * 4 + h];
    return -log1pf(__expf(-x));
}
__device__ __forceinline__ void p3_conv(Frame& F, int l, const int gw, const int NGW) {
    const int nrows = (l == DEPTH - 1) ? NLAT : MROWS;
    const int c = 4 * F.lane;
    const f32x4 w0 = *(const f32x4*)(F.in(9) + (l * 3 + 0) * 256 + c), w1 = *(const f32x4*)(F.in(9) + (l * 3 + 1) * 256 + c), w2 = *(const f32x4*)(F.in(9) + (l * 3 + 2) * 256 + c);
    for (int r0 = gw * 4; r0 < nrows; r0 += NGW * 4) {
        int t0, len; if (r0 < NLAT) { t0 = r0 & (SEQ - 1); len = SEQ; } else { t0 = (r0 - NLAT) & (CTXL - 1); len = CTXL; }
        const bf16_t* p = F.PROJ() + (size_t)r0 * INW + c;
        u32x2 ca[6], cx[6], gb[4];
#pragma unroll
        for (int d = 0; d < 6; ++d) { const int tt = t0 + d - 1; const bool ok = (tt >= 0 && tt < len); const bf16_t* pp = p + (ptrdiff_t)(ok ? d - 1 : 0) * INW;
            ca[d] = *(const u32x2*)(pp + C_CC); cx[d] = *(const u32x2*)(pp + C_CX); if (!ok) { ca[d] = (u32x2){0u, 0u}; } }
#pragma unroll
        for (int d = 0; d < 4; ++d) gb[d] = *(const u32x2*)(p + (size_t)d * INW + C_CB);
        f32x4 z[6];
#pragma unroll
        for (int d = 0; d < 6; ++d) z[d] = (f32x4){bflo(ca[d].x) * bflo(cx[d].x), bfhi(ca[d].x) * bfhi(cx[d].x), bflo(ca[d].y) * bflo(cx[d].y), bfhi(ca[d].y) * bfhi(cx[d].y)};
#pragma unroll
        for (int d = 0; d < 4; ++d) {
            const f32x4 cv = z[d] * w0 + z[d + 1] * w1 + z[d + 2] * w2;
            const f32x4 o = (f32x4){bflo(gb[d].x), bfhi(gb[d].x), bflo(gb[d].y), bfhi(gb[d].y)} * cv;
            u32x2 w; w.x = pk2(o[0], o[1]); w.y = pk2(o[2], o[3]);
            *(u32x2*)(F.MIX() + (size_t)(r0 + d) * D + c) = w;
        }
    }
}
__device__ __forceinline__ int chunk_row0(int b, int u) { return u < 2 ? NLAT + b * CTXL + u * 128 : b * SEQ + (u - 2) * 128; }
struct UsLoad { u32x4 kq[2], vq[2]; };
__device__ __forceinline__ void p3_ustate_load(Frame& F, int b, int h, int u, UsLoad& L) {
    const int row0 = chunk_row0(b, u);
#pragma unroll
    for (int r = 0; r < 2; ++r) {
        const int idx = F.tid + r * NTHREADS, tok = idx >> 3, c = idx & 7;
        const bf16_t* p = F.PROJ() + (size_t)(row0 + tok) * INW + h * 64 + 8 * c;
        L.kq[r] = *(const u32x4*)(p + C_RK); L.vq[r] = *(const u32x4*)(p + C_RV);
    }
}
typedef short v4i16_t __attribute__((ext_vector_type(4)));
__device__ __forceinline__ bf16x8 tr_frag(const LAS unsigned char* img, int pitch, int r0, int c0, int lane) {
    const int i = lane & 15, g = lane >> 4;
    const LAS unsigned char* p = img + (r0 + 8 * g + (i >> 2)) * pitch + (c0 + 4 * (i & 3)) * 2;
    const v4i16_t lo = __builtin_amdgcn_ds_read_tr16_b64_v4i16((LAS v4i16_t*)p), hi = __builtin_amdgcn_ds_read_tr16_b64_v4i16((LAS v4i16_t*)(p + 4 * pitch));
    return (bf16x8){lo[0], lo[1], lo[2], lo[3], hi[0], hi[1], hi[2], hi[3]};
}
__device__ __forceinline__ void p3_ustate_stage(Frame& F, int l, int h, const UsLoad& L) {
    constexpr int PT = 144;
    LAS unsigned char* Kf = F.lds; LAS unsigned char* Kb = F.lds + 128 * PT; LAS unsigned char* Vs = F.lds + 256 * PT;
    const float lgf = log_gamma(F, l, 0, h) * LOG2E, lgb = log_gamma(F, l, 1, h) * LOG2E;
#pragma unroll
    for (int r = 0; r < 2; ++r) {
        const int idx = F.tid + r * NTHREADS, tok = idx >> 3, c = idx & 7;
        const float wf = fexp2(lgf * (float)(127 - tok)), wb = fexp2(lgb * (float)tok);
        u32x4 kf, kb;
#pragma unroll
        for (int i = 0; i < 4; ++i) { const unsigned kw = L.kq[r][i]; const float k0 = bflo(kw), k1 = bfhi(kw); kf[i] = pk2(k0 * wf, k1 * wf); kb[i] = pk2(k0 * wb, k1 * wb); }
        *(LAS u32x4*)(Kf + tok * PT + c * 16) = kf; *(LAS u32x4*)(Kb + tok * PT + c * 16) = kb; *(LAS u32x4*)(Vs + tok * PT + c * 16) = L.vq[r];
    }
}
__device__ __forceinline__ void p3_ustate_mma(Frame& F, int b, int h, int u) {
    constexpr int PT = 144;
    LAS unsigned char* Kf = F.lds; LAS unsigned char* Kb = F.lds + 128 * PT; LAS unsigned char* Vs = F.lds + 256 * PT;
    const int fr = F.lane & 15, fq = F.lane >> 4, dkt = F.wave >> 1;
#pragma unroll
    for (int dir = 0; dir < 2; ++dir) {
        LAS unsigned char* Ks = dir ? Kb : Kf;
#pragma unroll
        for (int dd = 0; dd < 2; ++dd) {
            const int dvt = (F.wave & 1) * 2 + dd;
            f32x4 acc = (f32x4){0.f, 0.f, 0.f, 0.f};
#pragma unroll
            for (int s = 0; s < 4; ++s) {
                const bf16x8 af = tr_frag(Ks, PT, 32 * s, dkt * 16, F.lane);
                const bf16x8 bf = tr_frag(Vs, PT, 32 * s, dvt * 16, F.lane);
                acc = __builtin_amdgcn_mfma_f32_16x16x32_bf16(af, bf, acc, 0, 0, 0);
            }
            float* up = F.U() + ((size_t)(((dir * BATCH + b) * 4 + h) * NCHUNK + u)) * 4096 + (dvt * 16 + fr) * 64 + dkt * 16 + 4 * fq;
            *(f32x4*)up = acc;
        }
    }
}
__device__ __forceinline__ void p3_ustates(Frame& F, int l, int first, int stride) {
    constexpr int NIT = BATCH * 4 * NCHUNK;
    if (first >= NIT) return;
    UsLoad L;
    p3_ustate_load(F, (first / NCHUNK) >> 2, (first / NCHUNK) & 3, first % NCHUNK, L);
    for (int it = first; it < NIT; it += stride) {
        const int u = it % NCHUNK, bh = it / NCHUNK;
        __syncthreads();
        p3_ustate_stage(F, l, bh & 3, L);
        __syncthreads();
        const int nx = it + stride;
        if (nx < NIT) p3_ustate_load(F, (nx / NCHUNK) >> 2, (nx / NCHUNK) & 3, nx % NCHUNK, L);
        p3_ustate_mma(F, bh >> 2, bh & 3, u);
    }
}
typedef float f32x16 __attribute__((ext_vector_type(16)));
#ifndef ATT_THR
#define ATT_THR 5.0f
#endif
__device__ __forceinline__ int crow(int reg, int h) { return (reg & 3) + 8 * (reg >> 2) + 4 * h; }
__device__ __forceinline__ void p3_attn_item(Frame& F, int l, int b, int kvh, int qb, bool is_ctx) {
    constexpr int PK = 144, PV = 136, BUF = 64 * PK + 64 * PV;
    const int lane = F.lane, r = lane & 31, h = lane >> 5, g = F.wave >> 1, hw = F.wave & 1, hq = kvh * 4 + g;
    const int tq0 = qb * 128 + hw * 64;
    const int qrow0 = is_ctx ? NLAT + b * CTXL + tq0 : b * SEQ + tq0;
    bf16x8 qf[2][4];
#pragma unroll
    for (int qt = 0; qt < 2; ++qt)
#pragma unroll
        for (int s = 0; s < 4; ++s) qf[qt][s] = *(const bf16x8*)(F.PROJ() + (size_t)(qrow0 + qt * 32 + r) * INW + C_AQ + hq * 64 + 16 * s + 8 * h);
    f32x16 o[2][2];
#pragma unroll
    for (int dt = 0; dt < 2; ++dt)
#pragma unroll
        for (int qt = 0; qt < 2; ++qt)
#pragma unroll
            for (int i = 0; i < 16; ++i) o[dt][qt][i] = 0.f;
    float mrun[2], lrun[2];
    const float sink = F.in(11)[l * 8 + hq];
#pragma unroll
    for (int qt = 0; qt < 2; ++qt) { mrun[qt] = sink; lrun[qt] = (h == 0) ? 1.0f : 0.0f; }
    const int ti0 = (!is_ctx && qb == 0) ? 2 : 0;
    const int nwin = is_ctx ? 0 : 6 - ti0 - ((qb == SEQ / 128 - 1) ? 2 : 0);
    const int ntile = nwin + 4;
    const int skey = F.tid >> 3, sc = F.tid & 7;
    u32x4 kq, vq;
#define ATT_ROWBASE(i) ((i) < nwin ? b * SEQ + qb * 128 - 128 + 64 * (ti0 + (i)) : NLAT + b * CTXL + 64 * ((i) - nwin))
#define ATT_LOAD(i) do { const bf16_t* p_ = F.PROJ() + (size_t)(ATT_ROWBASE(i) + skey) * INW + kvh * 64 + 8 * sc; kq = *(const u32x4*)(p_ + C_AK); vq = *(const u32x4*)(p_ + C_AV); } while (0)
#define ATT_STORE(buf) do { LAS unsigned char* Ks_ = F.lds + (buf) * BUF; LAS unsigned char* Vt_ = Ks_ + 64 * PK; \
        *(LAS u32x4*)(Ks_ + skey * PK + sc * 16) = kq; \
        _Pragma("unroll") for (int i_ = 0; i_ < 4; ++i_) { const unsigned vw_ = vq[i_]; \
            *(LAS bf16_t*)(Vt_ + (8 * sc + 2 * i_) * PV + skey * 2) = (bf16_t)(vw_ & 0xffffu); *(LAS bf16_t*)(Vt_ + (8 * sc + 2 * i_ + 1) * PV + skey * 2) = (bf16_t)(vw_ >> 16); } } while (0)
    ATT_LOAD(0);
    __syncthreads();
    ATT_STORE(0);
    int cur = 0;
    for (int it = 0; it < ntile; ++it) {
        __syncthreads();
        if (it + 1 < ntile) ATT_LOAD(it + 1);
        const bool win = it < nwin;
        const int ti = ti0 + it;
        const bool part = win ? (hw == 0 ? ti <= 4 : ti >= 1) : true;
        if (part) {
            const LAS unsigned char* Ks = F.lds + cur * BUF; const LAS unsigned char* Vt = Ks + 64 * PK;
            const bool mask = win && (hw == 0 ? (ti == 0 || ti == 4) : (ti == 1 || ti == 5));
            const int tk = qb * 128 - 128 + 64 * ti;
#pragma unroll
            for (int qt = 0; qt < 2; ++qt) {
                f32x16 st[2];
#pragma unroll
                for (int kt = 0; kt < 2; ++kt) {
#pragma unroll
                    for (int i = 0; i < 16; ++i) st[kt][i] = 0.f;
#pragma unroll
                    for (int s = 0; s < 4; ++s) { const bf16x8 kf = *(const LAS bf16x8*)(Ks + (kt * 32 + r) * PK + (16 * s + 8 * h) * 2); st[kt] = __builtin_amdgcn_mfma_f32_32x32x16_bf16(kf, qf[qt][s], st[kt], 0, 0, 0); }
                }
                if (mask) {
#pragma unroll
                    for (int kt = 0; kt < 2; ++kt)
#pragma unroll
                        for (int i = 0; i < 16; ++i) { const int dlt = (tq0 + qt * 32 + r) - (tk + kt * 32 + crow(i, h)); if (dlt > 128 || dlt < -128) st[kt][i] = -INFINITY; }
                }
                float mx = st[0][0];
#pragma unroll
                for (int kt = 0; kt < 2; ++kt)
#pragma unroll
                    for (int i = 0; i < 16; ++i) mx = fmaxf(mx, st[kt][i]);
                mx = max_x32(mx);
                float alpha = 1.0f;
                const bool resc = !__all(mx - mrun[qt] <= ATT_THR);
                if (resc) { const float mnew = fmaxf(mrun[qt], mx); alpha = fexp(mrun[qt] - mnew); mrun[qt] = mnew; }
                const float mneg = -mrun[qt] * LOG2E;
                float ps = 0.f;
                bf16x8 pb[2][2];
#pragma unroll
                for (int kt = 0; kt < 2; ++kt)
#pragma unroll
                    for (int s = 0; s < 2; ++s) {
                        float e[8];
#pragma unroll
                        for (int j = 0; j < 8; ++j) { e[j] = fexp2(st[kt][8 * s + j] * LOG2E + mneg); ps += e[j]; }
                        u32x4 w; w.x = pk2(e[0], e[1]); w.y = pk2(e[2], e[3]); w.z = pk2(e[4], e[5]); w.w = pk2(e[6], e[7]);
                        pb[kt][s] = __builtin_bit_cast(bf16x8, w);
                    }
                lrun[qt] = lrun[qt] * alpha + ps;
#pragma unroll
                for (int dt = 0; dt < 2; ++dt) {
                    if (resc) {
#pragma unroll
                        for (int i = 0; i < 16; ++i) o[dt][qt][i] *= alpha;
                    }
#pragma unroll
                    for (int kt = 0; kt < 2; ++kt)
#pragma unroll
                        for (int s = 0; s < 2; ++s) {
                            const LAS unsigned char* vp = Vt + (dt * 32 + r) * PV + (kt * 32 + 16 * s + 4 * h) * 2;
                            const u32x2 v0 = *(const LAS u32x2*)vp, v1 = *(const LAS u32x2*)(vp + 16);
                            u32x4 vw; vw.x = v0.x; vw.y = v0.y; vw.z = v1.x; vw.w = v1.y;
                            o[dt][qt] = __builtin_amdgcn_mfma_f32_32x32x16_bf16(__builtin_bit_cast(bf16x8, vw), pb[kt][s], o[dt][qt], 0, 0, 0);
                        }
                }
                __builtin_amdgcn_sched_barrier(0);
            }
        }
        if (it + 1 < ntile) ATT_STORE(cur ^ 1);
        cur ^= 1;
    }
#pragma unroll
    for (int qt = 0; qt < 2; ++qt) {
        const float inv = 1.0f / sum_x32(lrun[qt]);
        bf16_t* op = F.MIX() + (size_t)(qrow0 + qt * 32 + r) * D + 512 + hq * 64 + 4 * h;
#pragma unroll
        for (int dt = 0; dt < 2; ++dt)
#pragma unroll
            for (int g4 = 0; g4 < 4; ++g4) { u32x2 w; w.x = pk2(o[dt][qt][4 * g4] * inv, o[dt][qt][4 * g4 + 1] * inv); w.y = pk2(o[dt][qt][4 * g4 + 2] * inv, o[dt][qt][4 * g4 + 3] * inv);
                *(u32x2*)(op + dt * 32 + 8 * g4) = w; }
    }
#undef ATT_ROWBASE
#undef ATT_LOAD
#undef ATT_STORE
}
#ifndef ATT_REP
#define ATT_REP 1
#endif
#ifndef UST_REP
#define UST_REP 1
#endif
#ifndef CONV_REP
#define CONV_REP 1
#endif
__device__ __forceinline__ void p3_mix(Frame& F, int l) {
    const bool lastl = (l == DEPTH - 1);
    for (int rr = 0; rr < ATT_REP; ++rr) { const int it = F.vcu  ; const int b = it >> 6, kvh = (it >> 5) & 1, qb = it & 31; p3_attn_item(F, l, b, kvh, qb, false); }
    const int nlight = lastl ? 0 : 16;
    if (F.bid < nlight) { const int j = F.bid; p3_attn_item(F, l, j >> 2, (j >> 1) & 1, j & 1, true); }
    else {
        __syncthreads();
        const int lb = F.bid - nlight, nl = F.G - nlight;
        for (int rr = 0; rr < UST_REP; ++rr) p3_ustates(F, l, lb, nl);
        if (lastl) {
        for (int rr = 0; rr < CONV_REP; ++rr)
        p3_conv(F, l, lb * NWAVES + F.wave, nl * NWAVES);
        }
    }
}

__device__ __forceinline__ void p3b_scan(Frame& F, int l) {
    for (int idx = F.bid * NTHREADS + F.tid; idx < 2 * BATCH * 4 * 4096; idx += F.G * NTHREADS) {
        const int dir = idx >> 16, rem = idx & 65535, bh = rem >> 12, el = rem & 4095;
        const float dec = fexp2(log_gamma(F, l, dir, bh & 3) * LOG2E * 128.0f);
        const float* up = F.U() + (size_t)((dir * 16 + bh) * NCHUNK) * 4096 + el;
        bf16_t* sp = F.ST() + (size_t)((dir * 16 + bh) * NCHUNK) * 4096 + el;
        float uv[NCHUNK];
#pragma unroll
        for (int u = 0; u < NCHUNK; ++u) uv[u] = up[(size_t)u * 4096];
        float s = 0.f;
        if (dir == 0) {
#pragma unroll
            for (int u = 0; u < NCHUNK; ++u) { sp[(size_t)u * 4096] = (bf16_t)(pk2(s, 0.f) & 0xffffu); s = dec * s + uv[u]; }
        } else {
            sp[(size_t)1 * 4096] = (bf16_t)(pk2(s, 0.f) & 0xffffu); s = dec * s + uv[1];
            sp[(size_t)0 * 4096] = (bf16_t)(pk2(s, 0.f) & 0xffffu); s = dec * s + uv[0];
#pragma unroll
            for (int u = NCHUNK - 1; u >= 2; --u) { sp[(size_t)u * 4096] = (bf16_t)(pk2(s, 0.f) & 0xffffu); s = dec * s + uv[u]; }
        }
    }
}

__device__ __forceinline__ void p4_ret_item(Frame& F, int l, int b, int h, int u) {
    constexpr int PK = 144, PT = 272;
    LAS unsigned char* Ks = F.lds; LAS unsigned char* Vs = F.lds + 128 * PK; LAS unsigned char* Pw = F.lds + 256 * PK + F.wave * (16 * PT);
    const int lane = F.lane, fr = lane & 15, fq = lane >> 4;
    const int row0 = chunk_row0(b, u);
    const int qi = F.wave * 16 + fr;
    const int qrow = row0 + qi;
    u32x4 kq[2], vq[2];
#pragma unroll
    for (int r = 0; r < 2; ++r) {
        const int idx = F.tid + r * NTHREADS, tok = idx >> 3, c = idx & 7;
        const bf16_t* p = F.PROJ() + (size_t)(row0 + tok) * INW + h * 64 + 8 * c;
        kq[r] = *(const u32x4*)(p + C_RK); vq[r] = *(const u32x4*)(p + C_RV);
    }
    bf16x8 qf[2];
#pragma unroll
    for (int s = 0; s < 2; ++s) qf[s] = *(const bf16x8*)(F.PROJ() + (size_t)qrow * INW + C_RQ + h * 64 + 32 * s + 8 * fq);
    u32x2 gq[2][4]; bf16x8 sf[2][2][4];
#pragma unroll
    for (int dir = 0; dir < 2; ++dir) {
        const bf16_t* gp = F.PROJ() + (size_t)qrow * INW + (dir == 0 ? C_RGF : C_RGB) + h * 64 + 4 * fq;
        const bf16_t* stp = F.ST() + (size_t)(((dir * BATCH + b) * 4 + h) * NCHUNK + u) * 4096;
#pragma unroll
        for (int dt = 0; dt < 4; ++dt) { gq[dir][dt] = *(const u32x2*)(gp + dt * 16);
#pragma unroll
            for (int s = 0; s < 2; ++s) sf[dir][s][dt] = *(const bf16x8*)(stp + (dt * 16 + fr) * 64 + 32 * s + 8 * fq); }
    }
    __syncthreads();
#pragma unroll
    for (int r = 0; r < 2; ++r) {
        const int idx = F.tid + r * NTHREADS, tok = idx >> 3, c = idx & 7;
        *(LAS u32x4*)(Ks + tok * PK + c * 16) = kq[r]; *(LAS u32x4*)(Vs + tok * PK + c * 16) = vq[r];
    }
    __syncthreads();
    f32x4 st[8];
#pragma unroll
    for (int kt = 0; kt < 8; ++kt) {
        const bf16x8 k0 = *(const LAS bf16x8*)(Ks + (kt * 16 + fr) * PK + (8 * fq) * 2), k1 = *(const LAS bf16x8*)(Ks + (kt * 16 + fr) * PK + (32 + 8 * fq) * 2);
        f32x4 z = (f32x4){0.f, 0.f, 0.f, 0.f};
        z = __builtin_amdgcn_mfma_f32_16x16x32_bf16(k0, qf[0], z, 0, 0, 0);
        st[kt] = __builtin_amdgcn_mfma_f32_16x16x32_bf16(k1, qf[1], z, 0, 0, 0);
    }
    f32x4 res[4];
#pragma unroll
    for (int dt = 0; dt < 4; ++dt) res[dt] = (f32x4){0.f, 0.f, 0.f, 0.f};
#pragma unroll
    for (int dir = 0; dir < 2; ++dir) {
        const float lg2 = log_gamma(F, l, dir, h) * LOG2E;
#pragma unroll
        for (int kt = 0; kt < 8; ++kt) {
            f32x4 p;
#pragma unroll
            for (int r = 0; r < 4; ++r) { const int j = kt * 16 + 4 * fq + r; const int df = dir == 0 ? qi - j : j - qi; p[r] = df >= 0 ? st[kt][r] * fexp2(lg2 * (float)df) : 0.f; }
            u32x2 w; w.x = pk2(p[0], p[1]); w.y = pk2(p[2], p[3]);
            *(LAS u32x2*)(Pw + fr * PT + (kt * 16 + 4 * fq) * 2) = w;
        }
        f32x4 o[4];
#pragma unroll
        for (int dt = 0; dt < 4; ++dt) o[dt] = (f32x4){0.f, 0.f, 0.f, 0.f};
#pragma unroll
        for (int s = 0; s < 4; ++s) {
            const bf16x8 pf = *(const LAS bf16x8*)(Pw + fr * PT + (32 * s + 8 * fq) * 2);
#pragma unroll
            for (int dt = 0; dt < 4; ++dt) { const bf16x8 vf = tr_frag(Vs, PK, 32 * s, dt * 16, lane); o[dt] = __builtin_amdgcn_mfma_f32_16x16x32_bf16(vf, pf, o[dt], 0, 0, 0); }
        }
        f32x4 tt[4];
#pragma unroll
        for (int dt = 0; dt < 4; ++dt) tt[dt] = (f32x4){0.f, 0.f, 0.f, 0.f};
#pragma unroll
        for (int s = 0; s < 2; ++s)
#pragma unroll
            for (int dt = 0; dt < 4; ++dt) tt[dt] = __builtin_amdgcn_mfma_f32_16x16x32_bf16(sf[dir][s][dt], qf[s], tt[dt], 0, 0, 0);
        const float qdec = fexp2(lg2 * (float)(dir == 0 ? qi + 1 : 128 - qi));
        float sm = 0.f;
#pragma unroll
        for (int dt = 0; dt < 4; ++dt) { o[dt] = o[dt] + tt[dt] * qdec; sm += (o[dt][0] + o[dt][1]) + (o[dt][2] + o[dt][3]); }
        sm = sum_x16(sm); sm = sum_x32(sm);
        const float mean = sm * (1.0f / 64.0f);
        float vr = 0.f;
#pragma unroll
        for (int dt = 0; dt < 4; ++dt) { o[dt] = o[dt] - mean; vr += (o[dt][0] * o[dt][0] + o[dt][1] * o[dt][1]) + (o[dt][2] * o[dt][2] + o[dt][3] * o[dt][3]); }
        vr = sum_x16(vr); vr = sum_x32(vr);
        const float rstd = 1.0f / sqrtf(vr * (1.0f / 64.0f) + EPS);
#pragma unroll
        for (int dt = 0; dt < 4; ++dt) { const u32x2 g_ = gq[dir][dt];
            const f32x4 gv = (f32x4){bflo(g_.x), bfhi(g_.x), bflo(g_.y), bfhi(g_.y)};
#pragma unroll
            for (int r = 0; r < 4; ++r) res[dt][r] += o[dt][r] * rstd * silu_f(gv[r]); }
    }
    bf16_t* op = F.MIX() + (size_t)qrow * D + 256 + h * 64 + 4 * fq;
#pragma unroll
    for (int dt = 0; dt < 4; ++dt) { u32x2 w; w.x = pk2(res[dt][0], res[dt][1]); w.y = pk2(res[dt][2], res[dt][3]); *(u32x2*)(op + dt * 16) = w; }
}
__device__ __forceinline__ void p4_readout(Frame& F, int l) {
    const int u0 = (l == DEPTH - 1) ? 2 : 0, nu = NCHUNK - u0;
    for (int it = F.bid; it < BATCH * 4 * nu; it += F.G) { const int u = u0 + it % nu, bh = it / nu; p4_ret_item(F, l, bh >> 2, bh & 3, u); }
    if (l != DEPTH - 1) {
        const int nit = BATCH * 4 * nu, nmax = (nit + F.G - 1) / F.G; int nfull = nit - (nmax - 1) * F.G; if (nfull >= F.G) nfull = 0;
        if (F.bid >= nfull) p3_conv(F, l, (F.bid - nfull) * NWAVES + F.wave, (F.G - nfull) * NWAVES);
    }
}

constexpr int NK = 8;
constexpr int NPHASE = 2 + NK * DEPTH;
#ifndef PH_EN
#define PH_EN(k) 1
#endif
#ifndef PH_REP
#define PH_REP(k) 1
#endif

__global__ void __launch_bounds__(NTHREADS, 2) fwd_kernel(Args args) {
    extern __shared__ __attribute__((aligned(16))) unsigned char lds[];
    for (int u = threadIdx.x; u < (LDS_BYTES - LDSCTL_OFF) / 4; u += NTHREADS) ((LAS unsigned*)((LAS unsigned char*)lds + LDSCTL_OFF))[u] = 0u;
    __syncthreads();
    const int wslot = __builtin_amdgcn_readfirstlane((int)(threadIdx.x >> 6));
    const int lo = args.ph_lo, hi = args.ph_hi;
    volatile LAS unsigned* MISC = (volatile LAS unsigned*)((LAS unsigned char*)lds + MISC_OFF);
    XcdBarrier bar; bar.bar = (unsigned*)(args.ws + WS_CTL) + CW_BAR; bar.x = 0; bar.st = MISC + 8;
    if (hi - lo > 1) bar = xcd_barrier_post((unsigned*)(args.ws + WS_CTL) + CW_BAR, MISC + 8, wslot == 0 && __builtin_amdgcn_mbcnt_hi(~0u, __builtin_amdgcn_mbcnt_lo(~0u, 0u)) == 0);
    int ph = lo, rep = 0;
    while (ph < hi) {
        Frame F;
        F.lds = (LAS unsigned char*)lds;
        unsigned allm = ~0u; asm volatile("" : "+s"(allm));
        int ptid = wslot * 64 + (int)__builtin_amdgcn_mbcnt_hi(allm, __builtin_amdgcn_mbcnt_lo(allm, 0u)), pbid = blockIdx.x;
        F.ws = args.ws; F.ap = (const Args*)(uintptr_t)__builtin_amdgcn_kernarg_segment_ptr();
        asm volatile("" : "+s"(F.ws), "+s"(F.ap), "+v"(ptid), "+s"(pbid));
        F.tid = ptid; F.lane = ptid & 63; F.wave = __builtin_amdgcn_readfirstlane(ptid >> 6); F.bid = pbid;
        F.G = gridDim.x; F.vcu = (F.G % 8 == 0) ? (pbid % 8) * (F.G / 8) + pbid / 8 : pbid;
        const int kind = (ph == 0) ? 10 : (ph == NPHASE - 1) ? 0 : (ph - 1) % NK;
        int nrep = PH_REP(0);
#pragma unroll
        for (int kk = 1; kk <= 10; ++kk) if (kind == kk) nrep = PH_REP(kk);
        if (ph == 0) { if (PH_EN(10)) p0_prologue(F); }
        else if (ph == NPHASE - 1) { if (PH_EN(0)) p1_rows<false>(F, DEPTH); }
        else {
            const int l = (ph - 1) / NK, k = (ph - 1) % NK;
            const bool lastl = (l == DEPTH - 1);
            if (k == 0) { if (PH_EN(0)) { if (l <= 1) p1_rows<true>(F, l); else p1_rows<false>(F, l); } }
            else if (k == 1) { if (PH_EN(1)) {
                SchedDense S{MROWS / 256, INW / 256, (MROWS / 256) * (INW / 256), F.G, F.bid, (const char*)F.H(), (const char*)(F.WIN() + (size_t)l * INW * 1024), 1024};
                LAS float* lrope = (LAS float*)(F.lds + LDSCTL_OFF + 1024);
                ((LAS f32x4*)lrope)[F.tid] = ((const f32x4*)F.ROPE())[F.tid];
                __syncthreads();
                EpiIn E{F.PROJ(), lrope};
                pg8::gemm_phase(F.lds, F.tid, 1024, S, E);
            } }
            else if (k == 2) { if (PH_EN(2)) p3_mix(F, l); }
            else if (k == 3) { if (PH_EN(3)) p3b_scan(F, l); }
            else if (k == 4) { if (PH_EN(4)) p4_readout(F, l); }
            else if (k == 5) { if (PH_EN(5)) {
                unsigned* cnt5 = F.ctl() + CW_C5 + l * 128 * 64;
                SchedOut S{256, F.G, F.bid, (const char*)F.MIX(), (const char*)(F.WOUT() + (size_t)l * 1024 * 1024), cnt5};
                EpiOut E{Y1buf(F), F.MOD() + (size_t)l * 5 * 6144};
#ifndef OUT_REP
#define OUT_REP 1
#endif
#ifndef ROWS2_REP
#define ROWS2_REP 1
#endif
                for (int rr = 0; rr < OUT_REP; ++rr) pg8::gemm_phase(F.lds, F.tid, 1024, S, E);
                if (!lastl) p5_ctx_piece(F, l, cnt5);
                for (int rr = 0; rr < ROWS2_REP; ++rr) { if (rr) __syncthreads(); if (l == 0) p6_rows<true>(F, l, cnt5); else p6_rows<false>(F, l, cnt5); }
            } }
            else if (k == 6) { if (PH_EN(6)) p7_topk(F, l); }
            else { if (PH_EN(7)) {
                const int nM = lastl ? 8 : 9;
                constexpr size_t ESZ = FFN_FP8 ? 1 : 2;
                LAS int* lrows = (LAS int*)(F.lds + LDSCTL_OFF + 1024);
                SchedFfn S{nM, NE * nM * 8, NE * nM * 4, F.G, F.bid, (const char*)F.H(), (const char*)F.ACT(), (const char*)F.WGU() + (size_t)l * NE * 2048 * 1024 * ESZ, (const char*)F.WD() + (size_t)l * NE * 1024 * 1024 * ESZ,
                           lrows, F.ctl() + CW_C8 + l * 144 * 64};
                { pg8::Unit pu_; for (int i = 0; i < 5 && S.next(i, pu_); ++i) if ((pu_.t & 1) == 0 && F.tid < 256) lrows[i * 256 + F.tid] = F.ROWS()[pu_.e * EROWS + pu_.pm * 256 + F.tid]; }
                __syncthreads();
                EpiFfn E{(void*)F.ACT(), F.YB(), F.GATE()};
                pg8::gemm_phase(F.lds, F.tid, FFN_FP8 ? 512 : 1024, S, E);
            } }
        }
        if (++rep >= nrep) { rep = 0; ++ph; }
        if (ph < hi) xcd_barrier(bar, F.tid == 0);
    }
}

extern "C" void kernel_launch(void* const* d_in, const int* in_sizes, int n_in, void* d_out, int out_size, void* d_ws, size_t ws_size, hipStream_t stream) {
    static int grid = 0;
    if (grid == 0) {
        if (n_in != 18 || in_sizes[0] != NLAT * D || out_size != NLAT * D || ws_size < WS_END) {
            fprintf(stderr, "kernel_launch: unexpected shapes (n_in %d, in0 %d, out %d, ws %zu; need ws >= %zu); nothing launched\n", n_in, n_in > 0 ? in_sizes[0] : -1, out_size, ws_size, (size_t)WS_END);
            grid = -1; return; }
        int dev = 0, cus = 0, per_cu = 0;
        if (hipGetDevice(&dev) != hipSuccess || hipDeviceGetAttribute(&cus, hipDeviceAttributeMultiprocessorCount, dev) != hipSuccess) { grid = -1; return; }
        if (hipFuncSetAttribute((const void*)fwd_kernel, hipFuncAttributeMaxDynamicSharedMemorySize, LDS_BYTES) != hipSuccess) { fprintf(stderr, "kernel_launch: hipFuncSetAttribute failed\n"); grid = -1; return; }
        if (hipOccupancyMaxActiveBlocksPerMultiprocessor(&per_cu, (const void*)fwd_kernel, NTHREADS, LDS_BYTES) != hipSuccess || per_cu < 1)
            fprintf(stderr, "kernel_launch: note: occupancy query reports %d workgroups per CU\n", per_cu);
        (void)hipGetLastError();
        grid = cus;
    }
    if (grid < 0) return;
    if (hipMemsetAsync((char*)d_ws + WS_CTL, 0, CTL_ZERO_BYTES, stream) != hipSuccess) { fprintf(stderr, "kernel_launch: memset failed\n"); return; }
    Args a{};
    for (int i = 0; i < 18; ++i) a.in[i] = (const float*)d_in[i];
    a.out = (float*)d_out; a.ws = (unsigned char*)d_ws;
#if MK_PER_PHASE
    for (int ph = 0; ph < NPHASE; ++ph) {
        a.ph_lo = ph; a.ph_hi = ph + 1;
        hipLaunchKernelGGL(fwd_kernel, dim3(grid), dim3(NTHREADS), LDS_BYTES, stream, a);
    }
#else
    a.ph_lo = 0; a.ph_hi = NPHASE;
    void* kargs[] = {&a};
    hipError_t e = hipLaunchCooperativeKernel((const void*)fwd_kernel, dim3(grid), dim3(NTHREADS), kargs, LDS_BYTES, stream);
    if (e != hipSuccess) fprintf(stderr, "kernel_launch: cooperative launch failed: %s (grid %d)\n", hipGetErrorString(e), grid);
#endif
}
```

```cpp
#include <hip/hip_runtime.h>
#include <hip/hip_cooperative_groups.h>
#include <cstdio>
#include <cstdint>

#ifndef FFN_FP8
#define FFN_FP8 1
#endif
#ifndef MK_PER_PHASE
#define MK_PER_PHASE 0
#endif

#define GAS __attribute__((address_space(1)))
#define LAS __attribute__((address_space(3)))
typedef unsigned short bf16_t;
typedef short bf16x8 __attribute__((ext_vector_type(8)));
typedef float f32x4 __attribute__((ext_vector_type(4)));
typedef float f32x2 __attribute__((ext_vector_type(2)));
typedef unsigned u32x4 __attribute__((ext_vector_type(4)));
typedef unsigned u32x2 __attribute__((ext_vector_type(2)));
typedef __bf16 bf16x2_t __attribute__((ext_vector_type(2)));

constexpr int D = 1024, BATCH = 4, SEQ = 4096, DEPTH = 4, CTXL = 256;
constexpr int NLAT = BATCH * SEQ, NCTX = BATCH * CTXL, MROWS = NLAT + NCTX;
constexpr int INW = 2816;
constexpr int C_CB = 0, C_CC = 256, C_CX = 512, C_RQ = 768, C_RK = 1024, C_RV = 1280, C_RGF = 1536, C_RGB = 1792, C_AQ = 2048, C_AK = 2560, C_AV = 2688;
constexpr int NE = 16, CAP_L = 512, CAP_C = 32, EROWS = 2304;
constexpr int NCHUNK = 34;
constexpr float EPS = 1e-6f;
constexpr float LOG2E = 1.4426950408889634f;

constexpr size_t MiB = 1u << 20;
constexpr size_t WS_CTL = 0, CTL_ZERO_BYTES = 512 * 1024;
constexpr size_t WS_MOD = 1 * MiB;
constexpr size_t WS_ROPE = 1 * MiB + 512 * 1024;
constexpr size_t WS_AFF = 2 * MiB;
constexpr size_t WS_ROWS = 4 * MiB;
constexpr size_t WS_GATE = 4 * MiB + 256 * 1024;
constexpr size_t WS_INV = 5 * MiB;
constexpr size_t WS_X = 8 * MiB;
constexpr size_t WS_H = 76 * MiB;
constexpr size_t WS_PROJ = 110 * MiB;
constexpr size_t WS_MIX = 204 * MiB;
constexpr size_t WS_U = 238 * MiB;
constexpr size_t WS_ST = 256 * MiB;
constexpr size_t WS_ACT = 266 * MiB;
constexpr size_t WS_YB = 338 * MiB;
constexpr size_t WS_WIN = 410 * MiB;
constexpr size_t WS_WOUT = 432 * MiB;
constexpr size_t WS_WGU = 440 * MiB;
constexpr size_t WS_WD = 696 * MiB;
constexpr size_t WS_X1 = 824 * MiB;
constexpr size_t WS_END = 892 * MiB;
constexpr int CW_BAR = 4096;

constexpr int RING_BYTES = 131072;
constexpr int LDSCTL_OFF = RING_BYTES, MISC_OFF = LDSCTL_OFF + 320;
constexpr int LDS_BYTES = 147456;
constexpr int NWAVES = 8, NTHREADS = 512;

__device__ __forceinline__ unsigned pk2(float lo, float hi) { f32x2 v = {lo, hi}; bf16x2_t b = __builtin_convertvector(v, bf16x2_t); return __builtin_bit_cast(unsigned, b); }
__device__ __forceinline__ float bflo(unsigned w) { return __uint_as_float(w << 16); }
__device__ __forceinline__ float bfhi(unsigned w) { return __uint_as_float(w & 0xffff0000u); }
__device__ __forceinline__ float fexp2(float x) { return __builtin_amdgcn_exp2f(x); }
__device__ __forceinline__ float fexp(float x) { return __builtin_amdgcn_exp2f(x * LOG2E); }
__device__ __forceinline__ float silu_f(float x) { return x / (1.0f + __expf(-x)); }
__device__ __forceinline__ int shxi(int v, int o, int lane) {
    if (o == 1) return __builtin_amdgcn_update_dpp(v, v, 0xB1, 0xf, 0xf, false);
    if (o == 2) return __builtin_amdgcn_update_dpp(v, v, 0x4E, 0xf, 0xf, false);
    if (o == 4) { const int t = __builtin_amdgcn_update_dpp(v, v, 0x104, 0xf, 0x5, false);
                  return __builtin_amdgcn_update_dpp(t, v, 0x114, 0xf, 0xa, false); }
    if (o == 8) return __builtin_amdgcn_update_dpp(v, v, 0x128, 0xf, 0xf, false);
    return __builtin_amdgcn_ds_bpermute((lane ^ o) << 2, v);
}
__device__ __forceinline__ float shx(float v, int o, int lane) { return __uint_as_float((unsigned)shxi((int)__float_as_uint(v), o, lane)); }
__device__ __forceinline__ float sum_x32(float v) { auto r = __builtin_amdgcn_permlane32_swap(__float_as_uint(v), __float_as_uint(v), false, false); return __uint_as_float(r[0]) + __uint_as_float(r[1]); }
__device__ __forceinline__ float sum_x16(float v) { auto r = __builtin_amdgcn_permlane16_swap(__float_as_uint(v), __float_as_uint(v), false, false); return __uint_as_float(r[0]) + __uint_as_float(r[1]); }
__device__ __forceinline__ float max_x32(float v) { auto r = __builtin_amdgcn_permlane32_swap(__float_as_uint(v), __float_as_uint(v), false, false); return fmaxf(__uint_as_float(r[0]), __uint_as_float(r[1])); }
__device__ __forceinline__ float max_x16(float v) { auto r = __builtin_amdgcn_permlane16_swap(__float_as_uint(v), __float_as_uint(v), false, false); return fmaxf(__uint_as_float(r[0]), __uint_as_float(r[1])); }
__device__ __forceinline__ float wave_sum(float v, int lane) {
    v += shx(v, 1, lane); v += shx(v, 2, lane); v += shx(v, 4, lane); v += shx(v, 8, lane); v = sum_x16(v); v = sum_x32(v);
    return v;
}
#define LDS_WAIT() asm volatile("s_waitcnt lgkmcnt(0)" ::: "memory")
#define VM_WAIT() asm volatile("s_waitcnt vmcnt(0)" ::: "memory")

#define XB_TMO      128
#define XB_XCNT(j)  (256  + 64 * (j))
#define XB_XSUB(j)  (1280 + 64 * (j))
#define XB_XGEN(j)  (2304 + 64 * (j))
#define XB_TOP      3328
#define XB_TOPGEN   3392
#define XCD_BAR_WORDS 3456
#define XB_SPIN_CAP (1u << 22)
__device__ __forceinline__ unsigned xb_ld(unsigned* p)              { return __hip_atomic_load(p, __ATOMIC_RELAXED, __HIP_MEMORY_SCOPE_AGENT); }
__device__ __forceinline__ unsigned xb_add(unsigned* p, unsigned v) { return __hip_atomic_fetch_add(p, v, __ATOMIC_RELAXED, __HIP_MEMORY_SCOPE_AGENT); }
__device__ __forceinline__ unsigned xb_xcc_id() { return (unsigned)__builtin_amdgcn_s_getreg((3 << 11) | 20) & 0xFu; }
#define XB_SPIN(cond, bar) do { unsigned _sp = 0; while (cond) { __builtin_amdgcn_s_sleep(1); \
    if ((++_sp & 255u) == 0u) { if (xb_ld(&(bar)[XB_TMO])) break; if (_sp > XB_SPIN_CAP) { atomicAdd(&(bar)[XB_TMO], 1u); break; } } } } while (0)
struct XcdBarrier { unsigned* bar; unsigned x; volatile LAS unsigned* st; };
__device__ __forceinline__ XcdBarrier xcd_barrier_post(unsigned* bar, volatile LAS unsigned* st, bool leader) {
    XcdBarrier b; b.bar = bar; b.x = xb_xcc_id(); b.st = st;
    if (leader) (void)xb_add(&bar[XB_XCNT(b.x)], 1u);
    return b;
}
__device__ __forceinline__ void xcd_barrier_complete(unsigned* bar, unsigned x, unsigned& nloc, unsigned& nx) {
    const unsigned G = gridDim.x * gridDim.y * gridDim.z;
    unsigned sum, cnt, mine, sp = 0u;
    for (;;) {
        sum = 0u; cnt = 0u; mine = 0u;
#pragma unroll
        for (unsigned j = 0; j < 16; ++j) { const unsigned c = xb_ld(&bar[XB_XCNT(j)]); sum += c; cnt += (c > 0u) ? 1u : 0u; mine = (j == x) ? c : mine; }
        if (sum == G) break;
        __builtin_amdgcn_s_sleep(1);
        if ((++sp & 255u) == 0u) { if (xb_ld(&bar[XB_TMO])) break; if (sp > XB_SPIN_CAP) { atomicAdd(&bar[XB_TMO], 1u); break; } }
    }
    nloc = mine > 0u ? mine : 1u; nx = cnt > 0u ? cnt : 1u;
}
__device__ __forceinline__ void xcd_barrier(const XcdBarrier& b, bool leader) {
    asm volatile("s_waitcnt vmcnt(0)" ::: "memory");
    __syncthreads();
    if (leader) {
        unsigned* bar = b.bar;
        __builtin_amdgcn_s_waitcnt(0);
        unsigned nloc = b.st[0], nx = b.st[1];
        if (nloc == 0u) { xcd_barrier_complete(bar, b.x, nloc, nx); b.st[0] = nloc; b.st[1] = nx; }
        const unsigned old = xb_add(&bar[XB_XSUB(b.x)], 1u);
        const unsigned gen = old / nloc;
        if (old + 1u == (gen + 1u) * nloc) {
            __builtin_amdgcn_fence(__ATOMIC_RELEASE, "agent");
            asm volatile("s_waitcnt vmcnt(0)" ::: "memory");
            asm volatile("buffer_inv sc1" ::: "memory");
            const unsigned og = xb_add(&bar[XB_TOP], 1u);
            const unsigned tg = og / nx;
            if (og + 1u == (tg + 1u) * nx) xb_add(&bar[XB_TOPGEN], 1u);
            else XB_SPIN(xb_ld(&bar[XB_TOPGEN]) == tg, bar);
            xb_add(&bar[XB_XGEN(b.x)], 1u);
            asm volatile("s_waitcnt vmcnt(0)" ::: "memory");
        } else {
            asm volatile("buffer_inv sc1" ::: "memory");
            XB_SPIN(xb_ld(&bar[XB_XGEN(b.x)]) == gen, bar);
            asm volatile("s_waitcnt vmcnt(0)" ::: "memory");
        }
    }
    __syncthreads();
}

namespace pg8 {
constexpr int BM = 256, BK = 64, HALF = 128, HTB = HALF * BK * 2, STAGE_BYTES = 8 * HTB, NXCD = 8, WGM = 8;
__host__ __device__ __forceinline__ int lds_byte(int r, int c) { const int st = (r >> 4) * 2 + (c >> 5), rr = r & 15, cc = c & 31, ob = rr * 64 + cc * 2; return st * 1024 + (ob ^ (((ob >> 9) & 1) << 5)); }
__host__ __device__ __forceinline__ void stage_rc(int b, int& R, int& C) { const int st = b / 1024, sb = b % 1024, swz = sb ^ (((sb >> 9) & 1) << 5); R = (st >> 1) * 16 + swz / 64; C = (st & 1) * 32 + (swz % 64) / 2; }
__host__ __device__ __forceinline__ int perm32(int rho) { const int n = rho >> 4, i = rho & 15; return 8 * (i >> 2) + 4 * n + (i & 3); }
struct Unit { int pm, pn, e, t; };
typedef int v4i_t __attribute__((ext_vector_type(4)));
typedef int v8i_t __attribute__((ext_vector_type(8)));

template <class Epi, class Sched>
__device__ __forceinline__ void gemm_phase(LAS unsigned char* lds, const int tid, const int K, const Sched& S, const Epi& E) {
    const int wid = __builtin_amdgcn_readfirstlane(tid >> 6), lane = tid & 63, wr = wid >> 2, wc = wid & 3, fr = lane & 15, fq = lane >> 4;
    const int nt = K / BK;
    int Rr[2]; unsigned cb[2], voffB[2];
#pragma unroll
    for (int i = 0; i < 2; ++i) { int R, C; stage_rc(tid * 16 + i * 8192, R, C); Rr[i] = R; cb[i] = (unsigned)C * 2u; const int Rb = Epi::PERM ? ((R & ~31) + perm32(R & 31)) : R; voffB[i] = (unsigned)(Rb * K + C) * 2u; }
    const size_t kstep = (size_t)(BK * 2);
    const size_t hstep = (size_t)HALF * K * 2;
    const unsigned rowb = (unsigned)K * 2u;
    const unsigned ldsw = (unsigned)wid * 1024u;
    const int aoff = lds_byte(wr * 64 + fr, fq * 8), boff = lds_byte(wc * 32 + fr, fq * 8);
#define PG8_SA(b, h) (((b) * 2 + (h)) * HTB)
#define PG8_SB(b, h) ((4 + (b) * 2 + (h)) * HTB)
#define PG8_STAGE(bufoff, gbase, voff) do { _Pragma("unroll") for (int _i = 0; _i < 2; ++_i) \
        __builtin_amdgcn_global_load_lds((const unsigned*)((const char*)(gbase) + (voff)[_i]), (LAS unsigned*)(lds + (bufoff) + ldsw + _i * 8192), 16, 0, 0); } while (0)
#define PG8_LDA(dst, b, h) do { if constexpr (Epi::FP8) { _Pragma("unroll") for (int m = 0; m < 4; ++m) dst##8[m] = __builtin_shufflevector(*(const LAS v4i_t*)(lds + PG8_SA(b, h) + aoff + m * 2048), *(const LAS v4i_t*)(lds + PG8_SA(b, h) + aoff + m * 2048 + 1024), 0, 1, 2, 3, 4, 5, 6, 7); } \
        else { _Pragma("unroll") for (int m = 0; m < 4; ++m) _Pragma("unroll") for (int k = 0; k < 2; ++k) dst[m][k] = *(const LAS bf16x8*)(lds + PG8_SA(b, h) + aoff + m * 2048 + k * 1024); } } while (0)
#define PG8_LDB(dst, b, h) do { if constexpr (Epi::FP8) { _Pragma("unroll") for (int n = 0; n < 2; ++n) dst##8[n] = __builtin_shufflevector(*(const LAS v4i_t*)(lds + PG8_SB(b, h) + boff + n * 2048), *(const LAS v4i_t*)(lds + PG8_SB(b, h) + boff + n * 2048 + 1024), 0, 1, 2, 3, 4, 5, 6, 7); } \
        else { _Pragma("unroll") for (int n = 0; n < 2; ++n) _Pragma("unroll") for (int k = 0; k < 2; ++k) dst[n][k] = *(const LAS bf16x8*)(lds + PG8_SB(b, h) + boff + n * 2048 + k * 1024); } } while (0)
#define PG8_MMA(ai, bj, At, Bt) do { __builtin_amdgcn_s_setprio(1); \
        if constexpr (Epi::FP8) { _Pragma("unroll") for (int m = 0; m < 4; ++m) _Pragma("unroll") for (int n = 0; n < 2; ++n) \
            asm volatile("v_mfma_scale_f32_16x16x128_f8f6f4 %0, %1, %2, %0, %3, %3 op_sel_hi:[0,0,0]" : "+v"(acc[ai][bj][m][n]) : "v"(Bt##8[n]), "v"(At##8[m]), "v"(sc1v)); } \
        else { _Pragma("unroll") for (int m = 0; m < 4; ++m) _Pragma("unroll") for (int n = 0; n < 2; ++n) _Pragma("unroll") for (int k = 0; k < 2; ++k) \
            acc[ai][bj][m][n] = __builtin_amdgcn_mfma_f32_16x16x32_bf16(Bt[n][k], At[m][k], acc[ai][bj][m][n], 0, 0, 0); } \
        __builtin_amdgcn_s_setprio(0); } while (0)
#define PG8_WAIT_V(n) asm volatile("s_waitcnt vmcnt(" #n ")" ::: "memory")
#define PG8_WAIT_L(n) asm volatile("s_waitcnt lgkmcnt(" #n ")" ::: "memory")
#define PG8_BAR __builtin_amdgcn_s_barrier()
#define PG8_SCHED __builtin_amdgcn_sched_barrier(0)
#define PG8_AOFFS(u, o0, o1) do { _Pragma("unroll") for (int _i = 0; _i < 2; ++_i) { o0[_i] = (unsigned)S.arow(u, Rr[_i]) * rowb + cb[_i]; o1[_i] = (unsigned)S.arow(u, HALF + Rr[_i]) * rowb + cb[_i]; } } while (0)
    Unit cur, nxt, pu; int ui = 0; bool pend = false;
    if (!S.next(0, cur)) return;
    pu = cur;
    f32x4 acc[2][2][4][2];
#pragma unroll
    for (int a = 0; a < 2; ++a)
#pragma unroll
        for (int b = 0; b < 2; ++b)
#pragma unroll
            for (int m = 0; m < 4; ++m)
#pragma unroll
                for (int n = 0; n < 2; ++n) acc[a][b][m][n] = (f32x4){0.f, 0.f, 0.f, 0.f};
    bf16x8 At[4][2], B0[2][2], B1[2][2];
    v8i_t At8[4], B08[2], B18[2];
    int sc1v = 0x7f7f7f7f; asm volatile("" : "+v"(sc1v));
    unsigned c0[2], c1[2], n0[2], n1[2];
    S.a_ready(cur, tid);
    PG8_AOFFS(cur, c0, c1);
    const char* cB = S.bbase(cur); const char* cA = S.abase(cur);
    PG8_STAGE(PG8_SB(0, 0), cB, voffB); PG8_STAGE(PG8_SB(0, 1), cB + hstep, voffB); PG8_STAGE(PG8_SA(0, 0), cA, c0); PG8_STAGE(PG8_SA(0, 1), cA, c1);
    if (wr == 1) PG8_BAR;
    PG8_WAIT_V(2); PG8_BAR;
    PG8_STAGE(PG8_SB(1, 0), cB + kstep, voffB); PG8_STAGE(PG8_SA(1, 0), cA + kstep, c0); PG8_STAGE(PG8_SB(1, 1), cB + hstep + kstep, voffB);
    PG8_WAIT_V(6); PG8_BAR;
    for (;;) {
        const bool has_next = S.next(ui + 1, nxt);
        const char* nB = cB; const char* nA = cA;
        if (has_next) { PG8_AOFFS(nxt, n0, n1); nB = S.bbase(nxt); nA = S.abase(nxt); }
        else {
#pragma unroll
            for (int i = 0; i < 2; ++i) { n0[i] = c0[i]; n1[i] = c1[i]; }
        }
        const bool halfm = Sched::HALFM ? ((cur.t & 2) != 0) : false;
        for (int t = 0; t < nt; t += 2) {
            const bool last = (t == nt - 2);
            if (last && has_next) S.a_ready(nxt, tid);
            const char* a1 = cA + (size_t)(t + 1) * kstep;
            const char* a2 = last ? nA : cA + (size_t)(t + 2) * kstep; const char* b2 = last ? nB : cB + (size_t)(t + 2) * kstep;
            const char* a3 = a2 + kstep; const char* b3 = b2 + kstep;
            unsigned x0[2], x1[2];
#pragma unroll
            for (int i = 0; i < 2; ++i) { x0[i] = last ? n0[i] : c0[i]; x1[i] = last ? n1[i] : c1[i]; }
            PG8_LDB(B0, 0, 0); PG8_LDB(B1, 0, 1); PG8_SCHED; PG8_LDA(At, 0, 0); PG8_STAGE(PG8_SA(1, 1), a1, c1);
            PG8_WAIT_V(8); PG8_WAIT_L(0); PG8_BAR; PG8_MMA(0, 0, At, B0); PG8_MMA(0, 1, At, B1); PG8_BAR; PG8_SCHED;
            if (!halfm) PG8_LDA(At, 0, 1);
            PG8_STAGE(PG8_SB(0, 0), b2, voffB); PG8_STAGE(PG8_SB(0, 1), b2 + hstep, voffB); PG8_STAGE(PG8_SA(0, 0), a2, x0);
            PG8_WAIT_V(8); PG8_WAIT_L(0); PG8_BAR; if (!halfm) { PG8_MMA(1, 0, At, B0); PG8_MMA(1, 1, At, B1); } PG8_BAR; PG8_SCHED;
            PG8_LDB(B0, 1, 0); PG8_LDB(B1, 1, 1); PG8_SCHED; PG8_LDA(At, 1, 0); PG8_STAGE(PG8_SA(0, 1), a2, x1);
            PG8_WAIT_V(8); PG8_WAIT_L(0); PG8_BAR; PG8_MMA(0, 0, At, B0); PG8_MMA(0, 1, At, B1); PG8_BAR; PG8_SCHED;
            if (!halfm) PG8_LDA(At, 1, 1);
            PG8_STAGE(PG8_SB(1, 0), b3, voffB); PG8_STAGE(PG8_SB(1, 1), b3 + hstep, voffB); PG8_STAGE(PG8_SA(1, 0), a3, x0);
            PG8_WAIT_V(8); PG8_WAIT_L(0); PG8_BAR; if (!halfm) { PG8_MMA(1, 0, At, B0); PG8_MMA(1, 1, At, B1); } PG8_BAR; PG8_SCHED;
            if constexpr (Sched::DEFER) { if (t == 0 && pend) { S.done(pu, lane); pend = false; } }
        }
        if constexpr (Epi::FP8) asm volatile("s_nop 15\n\ts_nop 15" ::: "memory");
        if (wr == 0) PG8_BAR;
        E(acc, cur, wr, wc, fr, fq);
        if constexpr (Sched::DEFER) { pu = cur; pend = true; } else { S.done(cur, lane); }
        if (!has_next) break;
#pragma unroll
        for (int a = 0; a < 2; ++a)
#pragma unroll
            for (int b = 0; b < 2; ++b)
#pragma unroll
                for (int m = 0; m < 4; ++m)
#pragma unroll
                    for (int n = 0; n < 2; ++n) acc[a][b][m][n] = (f32x4){0.f, 0.f, 0.f, 0.f};
        cur = nxt; cB = nB; cA = nA; ++ui;
#pragma unroll
        for (int i = 0; i < 2; ++i) { c0[i] = n0[i]; c1[i] = n1[i]; }
        if (wr == 1) PG8_BAR;
    }
    PG8_WAIT_V(0);
    if constexpr (Sched::DEFER) { if (pend) S.done(pu, lane); }
    PG8_BAR;
#undef PG8_SA
#undef PG8_SB
#undef PG8_STAGE
#undef PG8_LDA
#undef PG8_LDB
#undef PG8_MMA
#undef PG8_WAIT_V
#undef PG8_WAIT_L
#undef PG8_BAR
#undef PG8_SCHED
#undef PG8_AOFFS
}
}

struct Args { const float* in[18]; float* out; unsigned char* ws; int ph_lo, ph_hi; };
typedef const float* const __attribute__((address_space(4)))* kin_t;
struct Frame {
    LAS unsigned char* lds;
    int tid, lane, wave, vcu, G, bid;
    unsigned char* ws; const Args* ap;
    __device__ __forceinline__ const float* in(int i) const { return ((kin_t)(uintptr_t)ap)[i]; }
    __device__ __forceinline__ float* out() const { return (float*)((kin_t)(uintptr_t)ap)[18]; }
    __device__ __forceinline__ unsigned* ctl() const { return (unsigned*)(ws + WS_CTL); }
    __device__ __forceinline__ float* MOD() const { return (float*)(ws + WS_MOD); }
    __device__ __forceinline__ float* ROPE() const { return (float*)(ws + WS_ROPE); }
    __device__ __forceinline__ float* AFF() const { return (float*)(ws + WS_AFF); }
    __device__ __forceinline__ float* GATE() const { return (float*)(ws + WS_GATE); }
    __device__ __forceinline__ float* X() const { return (float*)(ws + WS_X); }
    __device__ __forceinline__ float* X1() const { return (float*)(ws + WS_X1); }
    __device__ __forceinline__ float* U() const { return (float*)(ws + WS_U); }
    __device__ __forceinline__ int* ROWS() const { return (int*)(ws + WS_ROWS); }
    __device__ __forceinline__ short* INV() const { return (short*)(ws + WS_INV); }
    __device__ __forceinline__ bf16_t* H() const { return (bf16_t*)(ws + WS_H); }
    __device__ __forceinline__ bf16_t* PROJ() const { return (bf16_t*)(ws + WS_PROJ); }
    __device__ __forceinline__ bf16_t* MIX() const { return (bf16_t*)(ws + WS_MIX); }
    __device__ __forceinline__ bf16_t* ST() const { return (bf16_t*)(ws + WS_ST); }
    __device__ __forceinline__ bf16_t* ACT() const { return (bf16_t*)(ws + WS_ACT); }
    __device__ __forceinline__ bf16_t* YB() const { return (bf16_t*)(ws + WS_YB); }
    __device__ __forceinline__ bf16_t* WIN() const { return (bf16_t*)(ws + WS_WIN); }
    __device__ __forceinline__ bf16_t* WOUT() const { return (bf16_t*)(ws + WS_WOUT); }
    __device__ __forceinline__ bf16_t* WGU() const { return (bf16_t*)(ws + WS_WGU); }
    __device__ __forceinline__ bf16_t* WD() const { return (bf16_t*)(ws + WS_WD); }
};

constexpr int CW_C5 = 16384;
constexpr int CW_C8 = 65536;
template <bool ACQ = true>
__device__ __forceinline__ void wait_counter(unsigned* cnt, unsigned need, int tid) {
    if (tid < 64) {
        unsigned polls = 0;
        while ((unsigned)__builtin_amdgcn_readfirstlane(__hip_atomic_load(cnt, __ATOMIC_RELAXED, __HIP_MEMORY_SCOPE_AGENT)) < need) {
            __builtin_amdgcn_s_sleep(2);
            if (++polls > (1u << 22)) break;
        }
        if (ACQ) __builtin_amdgcn_fence(__ATOMIC_ACQUIRE, "agent");
        asm volatile("s_waitcnt vmcnt(0)" ::: "memory");
    }
    asm volatile("" ::: "memory"); __builtin_amdgcn_s_barrier(); asm volatile("" ::: "memory");
}
__device__ __forceinline__ void arrive_counter(unsigned* cnt, int lane) {
    if (lane == 0) __hip_atomic_fetch_add(cnt, 1u, __ATOMIC_RELAXED, __HIP_MEMORY_SCOPE_AGENT);
}

struct SchedDense {
    static constexpr bool DEFER = false, HALFM = false;
    int nM, nN, nwg, G, c; const char* A; const char* Bt; int K;
    __device__ __forceinline__ bool next(int i, pg8::Unit& u) const {
        const long L = (long)i * G + c; if (L >= nwg) return false;
        int wgid = (int)L; { const int q = nwg / 8, r = nwg % 8, xcd = wgid % 8, off = wgid / 8; wgid = (xcd < r ? xcd * (q + 1) : r * (q + 1) + (xcd - r) * q) + off; }
        const int nig = 8 * nN, gid = wgid / nig, fm = gid * 8, gsz = (nM - fm) < 8 ? (nM - fm) : 8;
        u.pm = fm + ((wgid % nig) % gsz); u.pn = (wgid % nig) / gsz; u.e = 0; u.t = 0; return true;
    }
    __device__ __forceinline__ int arow(const pg8::Unit& u, int r) const { return u.pm * 256 + r; }
    __device__ __forceinline__ const char* abase(const pg8::Unit&) const { return A; }
    __device__ __forceinline__ const char* bbase(const pg8::Unit& u) const { return Bt + (size_t)u.pn * 256 * K * 2; }
    __device__ __forceinline__ void a_ready(const pg8::Unit&, int) const {}
    __device__ __forceinline__ void done(const pg8::Unit&, int) const {}
};
struct SchedOut {
    static constexpr bool DEFER = false, HALFM = false;
    int nwg, G, c; const char* A; const char* Bt; unsigned* cnt;
    __device__ __forceinline__ bool next(int i, pg8::Unit& u) const {
        const int L = i * G + c; if (L >= nwg) return false;
        if (L < 256) { const int wgid = (L % 8) * 32 + L / 8; u.pm = (wgid / 32) * 8 + (wgid % 32) % 8; u.pn = (wgid % 32) / 8; }
        else { const int j = L - 256; u.pm = 64 + j % 4; u.pn = j / 4; }
        u.e = 0; u.t = 0; return true;
    }
    __device__ __forceinline__ int arow(const pg8::Unit& u, int r) const { return u.pm * 256 + r; }
    __device__ __forceinline__ const char* abase(const pg8::Unit&) const { return A; }
    __device__ __forceinline__ const char* bbase(const pg8::Unit& u) const { return Bt + (size_t)u.pn * 256 * 1024 * 2; }
    __device__ __forceinline__ void a_ready(const pg8::Unit&, int) const {}
    __device__ __forceinline__ void done(const pg8::Unit& u, int lane) const { asm volatile("s_waitcnt vmcnt(0)" ::: "memory"); arrive_counter(cnt + 64 * u.pm, lane); }
};
struct SchedFfn {
    static constexpr bool DEFER = true;
    static constexpr bool HALFM = true;
    int nM, n8, n9, G, c; const char* Hb; const char* ACTb; const char* Wgu; const char* Wd; const LAS int* lrows; unsigned* cnt;
    __device__ __forceinline__ bool next(int i, pg8::Unit& u) const {
        if (nM == 9 && G == 256) {
            const int x = c & 7, cp = c >> 3;
            int k2 = -1;
            if (i < 4) { const int k = i * 32 + cp; u.t = i << 8; u.e = 2 * x + k / 64; const int r = k % 64; u.pn = r / 8; u.pm = r % 8; return true; }
            if (i == 4) { if (cp < 16) { u.t = (4 << 8) | 2; u.e = 2 * x + cp / 8; u.pn = cp % 8; u.pm = 8; return true; } k2 = cp - 16; }
            else if (i == 5) k2 = 16 + cp;
            else if (i == 6) { if (cp < 16) k2 = 48 + cp; else if (cp < 24) { const int k = cp - 16; u.t = 1 | 2 | (6 << 8); u.e = 2 * x + k / 4; u.pn = k % 4; u.pm = 8; return true; } else return false; }
            else return false;
            u.t = 1 | (i << 8); u.e = 2 * x + k2 / 32; u.pn = (k2 % 32) / 8; u.pm = k2 % 8; return true;
        }
        const int L = i * G + c; if (L >= n8 + n9) return false;
        if (L < n8) { u.t = i << 8; const int wgid = (L % 8) * (n8 / 8) + L / 8; const int per = nM * 8; u.e = wgid / per; const int r = wgid % per; u.pn = r / nM; u.pm = r % nM; if (u.pm == 8) u.t |= 2; }
        else { u.t = 1 | (i << 8); const int j = L - n8, half = n9 / 2, eh = j / half, jj = j % half; const int wgid = (jj % 8) * (half / 8) + jj / 8; const int per = nM * 4;
               u.e = 2 * (wgid / per) + eh; const int r = wgid % per; u.pn = r / nM; u.pm = r % nM; if (u.pm == 8) u.t |= 2; }
        return true;
    }
    __device__ __forceinline__ int arow(const pg8::Unit& u, int r) const { return (u.t & 1) == 0 ? lrows[(u.t >> 8) * 256 + r] : u.e * EROWS + u.pm * 256 + r; }
    __device__ __forceinline__ const char* abase(const pg8::Unit& u) const { return (u.t & 1) == 0 ? Hb : ACTb; }
    __device__ __forceinline__ const char* bbase(const pg8::Unit& u) const {
        constexpr size_t ESZ = FFN_FP8 ? 1 : 2;
        return (u.t & 1) == 0 ? Wgu + (size_t)u.e * 2048 * 1024 * ESZ + (size_t)u.pn * 256 * 1024 * ESZ : Wd + (size_t)u.e * 1024 * 1024 * ESZ + (size_t)u.pn * 256 * 1024 * ESZ; }
    __device__ __forceinline__ void a_ready(const pg8::Unit& u, int tid) const { if (u.t & 1) wait_counter(cnt + 64 * (u.e * 9 + u.pm), 64u, tid); }
    __device__ __forceinline__ void done(const pg8::Unit& u, int lane) const { if ((u.t & 1) == 0) arrive_counter(cnt + 64 * (u.e * 9 + u.pm), lane); }
};

__device__ __forceinline__ u32x4 pair16(unsigned ax, unsigned ay, unsigned bx, unsigned by) {
    const auto p = __builtin_amdgcn_permlane16_swap(ax, bx, false, false); const auto q = __builtin_amdgcn_permlane16_swap(ay, by, false, false);
    u32x4 w; w.x = p[0]; w.y = q[0]; w.z = p[1]; w.w = q[1]; return w;
}
struct EpiIn {
    static constexpr bool PERM = false, FP8 = false;
    bf16_t* O; const LAS float* rope;
    __device__ __forceinline__ void operator()(const f32x4 (&acc)[2][2][4][2], const pg8::Unit& u, int wr, int wc, int fr, int fq) const {
        if (u.pn == 1 || u.pn == 2) {
            const int colz = C_CC + (u.pn - 1) * 128 + wc * 32 + ((fq & 1) ? 16 + 4 * (fq - 1) : 4 * fq);
#pragma unroll
            for (int ai = 0; ai < 2; ++ai)
#pragma unroll
                for (int m = 0; m < 4; ++m) {
                    const int row = u.pm * 256 + ai * 128 + wr * 64 + m * 16 + fr;
                    const f32x4 z0 = acc[ai][0][m][0] * acc[ai][1][m][0], z1 = acc[ai][0][m][1] * acc[ai][1][m][1];
                    *(u32x4*)(O + (size_t)row * INW + colz) = pair16(pk2(z0[0], z0[1]), pk2(z0[2], z0[3]), pk2(z1[0], z1[1]), pk2(z1[2], z1[3]));
                }
            return;
        }
        const bool latent = u.pm < 64;
#pragma unroll
        for (int bj = 0; bj < 2; ++bj) {
            const int seg = 2 * u.pn + bj;
            const bool is_rope = latent && (seg == 6 || seg == 7 || seg == 8 || seg == 9 || (seg >= 16 && seg <= 20));
            const float sc = (seg == 8 || seg == 9 || (seg >= 16 && seg <= 19)) ? 0.125f : 1.0f;
            const int colb = u.pn * 256 + bj * 128 + wc * 32 + ((fq & 1) ? 16 + 4 * (fq - 1) : 4 * fq);
#pragma unroll
            for (int ai = 0; ai < 2; ++ai)
#pragma unroll
                for (int m = 0; m < 4; ++m) {
                    const int row = u.pm * 256 + ai * 128 + wr * 64 + m * 16 + fr;
                    f32x4 v0 = acc[ai][bj][m][0] * sc, v1 = acc[ai][bj][m][1] * sc;
                    if (is_rope) {
                        const int t = row & (SEQ - 1);
                        const int pos = (wc & 1) ? (t & 63) : (t >> 6);
                        const LAS float* cp = rope + pos * 16 + 4 * fq;
                        const f32x4 cs = *(const LAS f32x4*)cp, sn = *(const LAS f32x4*)(cp + 1024);
                        const f32x4 o0 = v0 * cs - v1 * sn, o1 = v1 * cs + v0 * sn;
                        v0 = o0; v1 = o1;
                    }
                    *(u32x4*)(O + (size_t)row * INW + colb) = pair16(pk2(v0[0], v0[1]), pk2(v0[2], v0[3]), pk2(v1[0], v1[1]), pk2(v1[2], v1[3]));
                }
        }
    }
};
struct EpiOut {
    static constexpr bool PERM = true, FP8 = false;
    bf16_t* Y1; const float* mod;
    __device__ __forceinline__ void operator()(const f32x4 (&acc)[2][2][4][2], const pg8::Unit& u, int wr, int wc, int fr, int fq) const {
        const int b = u.pm < 64 ? (u.pm >> 4) : 4;
        const float* g1 = mod + b * 6144 + 2048;
        const __amdgpu_buffer_rsrc_t rs = __builtin_amdgcn_make_buffer_rsrc((void*)Y1, (short)0, MROWS * D * 2, 0x00020000);
#pragma unroll
        for (int bj = 0; bj < 2; ++bj) {
            const int col = u.pn * 256 + bj * 128 + wc * 32 + 8 * fq;
            const f32x4 g0 = *(const f32x4*)(g1 + col), g1v = *(const f32x4*)(g1 + col + 4);
#pragma unroll
            for (int ai = 0; ai < 2; ++ai)
#pragma unroll
                for (int m = 0; m < 4; ++m) {
                    const int row = u.pm * 256 + ai * 128 + wr * 64 + m * 16 + fr;
                    const f32x4 r0 = g0 * acc[ai][bj][m][0], r1 = g1v * acc[ai][bj][m][1];
                    u32x4 w; w.x = pk2(r0[0], r0[1]); w.y = pk2(r0[2], r0[3]); w.z = pk2(r1[0], r1[1]); w.w = pk2(r1[2], r1[3]);
                    __builtin_amdgcn_raw_buffer_store_b128(w, rs, (unsigned)((row * D + col) * 2), 0, 16);
                }
        }
    }
};
__device__ __forceinline__ unsigned pk4_fp8(float a, float b, float c, float d) { unsigned w = 0u; w = __builtin_amdgcn_cvt_pk_fp8_f32(a, b, w, false); w = __builtin_amdgcn_cvt_pk_fp8_f32(c, d, w, true); return w; }
struct EpiFfn {
    static constexpr bool PERM = true, FP8 = (FFN_FP8 != 0);
    void* ACT; bf16_t* YB; const float* gate;
    __device__ __forceinline__ void operator()(const f32x4 (&acc)[2][2][4][2], const pg8::Unit& u, int wr, int wc, int fr, int fq) const {
        if ((u.t & 1) == 0) {
            constexpr float ASC = FP8 ? (1.0f / 32.0f) : 1.0f;
            constexpr float OSC = FP8 ? 8.0f : 1.0f;
            const __amdgpu_buffer_rsrc_t rs = __builtin_amdgcn_make_buffer_rsrc(ACT, (short)0, NE * EROWS * 1024 * (FP8 ? 1 : 2), 0x00020000);
#pragma unroll
            for (int ai = 0; ai < 2; ++ai) {
                if (ai == 1 && (u.t & 2)) break;
#pragma unroll
                for (int m = 0; m < 4; ++m) {
                    const int row = u.e * EROWS + u.pm * 256 + ai * 128 + wr * 64 + m * 16 + fr;
                    float r[8];
#pragma unroll
                    for (int n = 0; n < 2; ++n)
#pragma unroll
                        for (int q = 0; q < 4; ++q) { const float a = acc[ai][0][m][n][q] * ASC; r[4 * n + q] = a * __builtin_amdgcn_rcpf(1.0f + fexp(-a)) * (acc[ai][1][m][n][q] * (ASC * OSC)); }
                    if constexpr (FP8) {
                        const unsigned long long w = (unsigned long long)pk4_fp8(r[0], r[1], r[2], r[3]) | ((unsigned long long)pk4_fp8(r[4], r[5], r[6], r[7]) << 32);
                        __hip_atomic_store((unsigned long long*)((unsigned char*)ACT + (size_t)row * 1024 + u.pn * 128 + wc * 32 + 8 * fq), w, __ATOMIC_RELAXED, __HIP_MEMORY_SCOPE_AGENT);
                    } else {
                        u32x4 w; w.x = pk2(r[0], r[1]); w.y = pk2(r[2], r[3]); w.z = pk2(r[4], r[5]); w.w = pk2(r[6], r[7]);
                        __builtin_amdgcn_raw_buffer_store_b128(w, rs, (unsigned)((row * 1024 + u.pn * 128 + wc * 32 + 8 * fq) * 2), 0, 16);
                    }
                }
            }
        } else {
            constexpr float YSC = FP8 ? (64.0f / 256.0f) : 1.0f;
#pragma unroll
            for (int ai = 0; ai < 2; ++ai) {
                if (ai == 1 && (u.t & 2)) break;
#pragma unroll
                for (int m = 0; m < 4; ++m) {
                    const int row = u.e * EROWS + u.pm * 256 + ai * 128 + wr * 64 + m * 16 + fr;
                    const float gt = gate[row] * YSC;
#pragma unroll
                    for (int bj = 0; bj < 2; ++bj) {
                        const f32x4 r0 = acc[ai][bj][m][0] * gt, r1 = acc[ai][bj][m][1] * gt;
                        if constexpr (FP8) {
                            u32x2 w; w.x = pk4_fp8(r0[0], r0[1], r0[2], r0[3]); w.y = pk4_fp8(r1[0], r1[1], r1[2], r1[3]);
                            *(u32x2*)((unsigned char*)YB + (size_t)row * 1024 + u.pn * 256 + bj * 128 + wc * 32 + 8 * fq) = w;
                        } else {
                            u32x4 w; w.x = pk2(r0[0], r0[1]); w.y = pk2(r0[2], r0[3]); w.z = pk2(r1[0], r1[1]); w.w = pk2(r1[2], r1[3]);
                            *(u32x4*)(YB + (size_t)row * 1024 + u.pn * 256 + bj * 128 + wc * 32 + 8 * fq) = w;
                        }
                    }
                }
            }
        }
    }
};

__device__ __forceinline__ void p0_transpose_item(const float* W, int N, bf16_t* WT, int out_row0, LAS unsigned* scr, int kb, int n0, int lane) {
    const int k0 = 64 * kb;
    const float* wp = W + (size_t)k0 * N + n0 + lane;
#pragma unroll
    for (int g = 0; g < 2; ++g) {
        float t[32];
#pragma unroll
        for (int i = 0; i < 32; ++i) t[i] = __builtin_nontemporal_load(wp + (size_t)(32 * g + i) * N);
#pragma unroll
        for (int i = 0; i < 16; ++i) scr[(16 * g + i) * 65 + lane] = pk2(t[2 * i], t[2 * i + 1]);
    }
    LDS_WAIT(); asm volatile("" ::: "memory");
    const int c = lane & 7;
#pragma unroll
    for (int j = 0; j < 8; ++j) { const int n = (lane >> 3) + 8 * j; const LAS unsigned* sp = scr + (4 * c) * 65 + n;
        u32x4 o; o.x = sp[0]; o.y = sp[65]; o.z = sp[130]; o.w = sp[195];
        __builtin_nontemporal_store(o, (u32x4*)(WT + (size_t)(out_row0 + n) * 1024 + k0 + 8 * c)); }
    LDS_WAIT(); asm volatile("" ::: "memory");
}
#if FFN_FP8
__device__ __forceinline__ void p0_transpose_item8(const float* W, int N, unsigned char* WT, int out_row0, LAS unsigned* scr, int kb2, int n0, int lane) {
    const int k0 = 128 * kb2;
#pragma unroll
    for (int hf = 0; hf < 2; ++hf) {
        const float* wp = W + (size_t)(k0 + 64 * hf) * N + n0 + lane;
#pragma unroll
        for (int g = 0; g < 2; ++g) {
            float t[32];
#pragma unroll
            for (int i = 0; i < 32; ++i) t[i] = __builtin_nontemporal_load(wp + (size_t)(32 * g + i) * N) * 32.0f;
#pragma unroll
            for (int i = 0; i < 8; ++i) scr[(16 * hf + 8 * g + i) * 65 + lane] = pk4_fp8(t[4 * i], t[4 * i + 1], t[4 * i + 2], t[4 * i + 3]);
        }
    }
    LDS_WAIT(); asm volatile("" ::: "memory");
    const int c = lane & 7;
#pragma unroll
    for (int j = 0; j < 8; ++j) { const int n = (lane >> 3) + 8 * j; const LAS unsigned* sp = scr + (4 * c) * 65 + n;
        u32x4 o; o.x = sp[0]; o.y = sp[65]; o.z = sp[130]; o.w = sp[195];
        __builtin_nontemporal_store(o, (u32x4*)(WT + (size_t)(out_row0 + n) * 1024 + k0 + 16 * c)); }
    LDS_WAIT(); asm volatile("" ::: "memory");
}
#endif
constexpr int CV_IN = 16 * (INW / 64), CV_SQ = 16 * 16, CV_EX = FFN_FP8 ? 8 * 16 : CV_SQ, CV_LAYER = CV_IN + CV_SQ + NE * 3 * CV_EX;
__device__ __forceinline__ void convert_item(Frame& F, int l, int it, LAS unsigned* scr) {
    int r = it;
    if (r < CV_IN) { const int kb = r / (INW / 64), nb = r % (INW / 64);
        int orow = 64 * nb; if (orow >= C_CC && orow < C_RQ) { const int ch = (orow - C_CC) & 255, isx = orow >= C_CX; orow = C_CC + (ch >> 7) * 256 + isx * 128 + (ch & 127); }
        p0_transpose_item(F.in(8) + (size_t)l * 1024 * INW, INW, F.WIN() + (size_t)l * INW * 1024, orow, scr, kb, 64 * nb, F.lane); return; }
    r -= CV_IN;
    if (r < CV_SQ) { const int kb = r / 16, nb = r % 16;
        p0_transpose_item(F.in(12) + (size_t)l * 1024 * 1024, 1024, F.WOUT() + (size_t)l * 1024 * 1024, 64 * nb, scr, kb, 64 * nb, F.lane); return; }
    r -= CV_SQ;
    const int mat = r / CV_EX; r %= CV_EX; const int kb = r / 16, nb = r % 16; const int which = mat % 3, le = l * NE + mat / 3;
#if FFN_FP8
    unsigned char* wgu8 = (unsigned char*)F.WGU() + (size_t)le * 2048 * 1024; unsigned char* wd8 = (unsigned char*)F.WD() + (size_t)le * 1024 * 1024;
    if (which == 0) p0_transpose_item8(F.in(14) + (size_t)le * 1024 * 1024, 1024, wgu8, (nb >> 1) * 256 + (nb & 1) * 64, scr, kb, 64 * nb, F.lane);
    else if (which == 1) p0_transpose_item8(F.in(15) + (size_t)le * 1024 * 1024, 1024, wgu8, (nb >> 1) * 256 + 128 + (nb & 1) * 64, scr, kb, 64 * nb, F.lane);
    else p0_transpose_item8(F.in(16) + (size_t)le * 1024 * 1024, 1024, wd8, 64 * nb, scr, kb, 64 * nb, F.lane);
#else
    if (which == 0) p0_transpose_item(F.in(14) + (size_t)le * 1024 * 1024, 1024, F.WGU() + (size_t)le * 2048 * 1024, (nb >> 1) * 256 + (nb & 1) * 64, scr, kb, 64 * nb, F.lane);
    else if (which == 1) p0_transpose_item(F.in(15) + (size_t)le * 1024 * 1024, 1024, F.WGU() + (size_t)le * 2048 * 1024, (nb >> 1) * 256 + 128 + (nb & 1) * 64, scr, kb, 64 * nb, F.lane);
    else p0_transpose_item(F.in(16) + (size_t)le * 1024 * 1024, 1024, F.WD() + (size_t)le * 1024 * 1024, 64 * nb, scr, kb, 64 * nb, F.lane);
#endif
}
__device__ __forceinline__ void p0_prologue(Frame& F) {
    LAS unsigned* scr = (LAS unsigned*)(F.lds + F.wave * 16384);
    const int gw = F.vcu * NWAVES + F.wave, NGW = F.G * NWAVES;
    for (int it = gw; it < DEPTH * CV_LAYER; it += NGW) convert_item(F, it / CV_LAYER, it % CV_LAYER, scr);
    __syncthreads();
    LAS float* sS = (LAS float*)F.lds;
    LAS float* red = (LAS float*)(F.lds + 32768);
    for (int i = F.tid; i < 5 * 1024; i += NTHREADS) { const float v = i < 4096 ? F.in(1)[i] : F.in(3)[i - 4096]; sS[i] = silu_f(v); }
    __syncthreads();
    for (int item = F.bid; item < DEPTH * 96; item += F.G) {
        const int l = item / 96, jg = item % 96, j = jg * 64 + F.lane;
        const float* wp = F.in(4) + ((size_t)l * 1024 + F.wave * 128) * 6144 + j;
        float a0 = 0.f, a1 = 0.f, a2 = 0.f, a3 = 0.f, a4 = 0.f;
        float wa[16], wb[16];
#define MOD_LOAD(buf, k0_) do { _Pragma("unroll") for (int i_ = 0; i_ < 16; ++i_) buf[i_] = __builtin_nontemporal_load(wp + (size_t)((k0_) + i_) * 6144); } while (0)
#define MOD_USE(buf, k0_) do { _Pragma("unroll") for (int i_ = 0; i_ < 16; ++i_) { const float w = buf[i_]; const int k = F.wave * 128 + (k0_) + i_; \
            a0 += sS[k] * w; a1 += sS[1024 + k] * w; a2 += sS[2048 + k] * w; a3 += sS[3072 + k] * w; a4 += sS[4096 + k] * w; } } while (0)
        MOD_LOAD(wa, 0);
#pragma unroll 1
        for (int kk = 0; kk < 128; kk += 32) {
            MOD_LOAD(wb, kk + 16); __builtin_amdgcn_sched_barrier(0);
            MOD_USE(wa, kk); __builtin_amdgcn_sched_barrier(0);
            if (kk + 32 < 128) MOD_LOAD(wa, kk + 32);
            __builtin_amdgcn_sched_barrier(0);
            MOD_USE(wb, kk + 16); __builtin_amdgcn_sched_barrier(0);
        }
#undef MOD_LOAD
#undef MOD_USE
        red[(F.wave * 5 + 0) * 64 + F.lane] = a0; red[(F.wave * 5 + 1) * 64 + F.lane] = a1; red[(F.wave * 5 + 2) * 64 + F.lane] = a2;
        red[(F.wave * 5 + 3) * 64 + F.lane] = a3; red[(F.wave * 5 + 4) * 64 + F.lane] = a4;
        __syncthreads();
        if (F.tid < 320) { const int b = F.tid >> 6, ln = F.tid & 63; float s = F.in(5)[l * 6144 + jg * 64 + ln];
#pragma unroll
            for (int w = 0; w < 8; ++w) s += red[(w * 5 + b) * 64 + ln];
            F.MOD()[(size_t)(l * 5 + b) * 6144 + jg * 64 + ln] = s; }
        __syncthreads();
    }
    if (F.bid == F.G - 1) {
        for (int i = F.tid; i < 1024; i += NTHREADS) {
            const int pos = i >> 4, f = i & 15;
            const float invf = exp2f(-(float)f * (13.287712379549449f / 16.0f));
            const float angf = (float)pos * invf;
            double a = (double)angf; const double TWO_PI = 6.283185307179586476925;
            a -= TWO_PI * rint(a / TWO_PI);
            const double a2 = a * a; double cs = 1.0, sn = a, tc = 1.0, ts = a;
#pragma unroll 1
            for (int n = 1; n <= 12; ++n) { tc *= -a2 / (double)((2 * n - 1) * (2 * n)); ts *= -a2 / (double)((2 * n) * (2 * n + 1)); cs += tc; sn += ts; }
            F.ROPE()[i] = (float)cs; F.ROPE()[1024 + i] = (float)sn;
        }
    }
}

__device__ __forceinline__ f32x4 y1_quarter(const bf16_t* y1row, int lane, int j) { const u32x2 q = *(const u32x2*)(y1row + 4 * lane + 256 * j); return (f32x4){bflo(q.x), bfhi(q.x), bflo(q.y), bfhi(q.y)}; }
__device__ __forceinline__ const float* xsrc_row(const Frame& F, bool from_inputs, int row) {
    return from_inputs ? (row < NLAT ? F.in(0) + (size_t)row * D : F.in(2) + (size_t)(row - NLAT) * D) : F.X() + (size_t)row * D; }
__device__ __forceinline__ bf16_t* Y1buf(const Frame& F) { return (bf16_t*)(F.ws + WS_X1); }
__device__ __forceinline__ bf16_t* XBbuf(const Frame& F) { return (bf16_t*)(F.ws + WS_X); }
template <bool XIN> __device__ __forceinline__ const char* xrow_ptr(const Frame& F, int row) {
    if constexpr (XIN) return (const char*)xsrc_row(F, true, row); else return (const char*)(XBbuf(F) + (size_t)row * D); }
template <bool XIN> __device__ __forceinline__ f32x4 xrow_q(const char* p, int lane, int j) {
    if constexpr (XIN) return ((const f32x4*)p)[lane + 64 * j]; else return y1_quarter((const bf16_t*)p, lane, j); }
__device__ __forceinline__ void p1_one(Frame& F, int l, bool fin, int row, f32x4 (&v)[4], const u32x4 i0, const u32x4 i1, const f32x4 (&gm)[4], const f32x4 (&sh)[4], const f32x4 (&g2)[4]) {
    const int lane = F.lane;
    if (l > 0) {
        f32x4 ys[4];
#pragma unroll
        for (int j = 0; j < 4; ++j) ys[j] = (f32x4){0.f, 0.f, 0.f, 0.f};
#if FFN_FP8
        unsigned q[16][4];
#pragma unroll
        for (int e = 0; e < 16; ++e) {
            const unsigned w = (e < 8) ? i0[(e & 7) >> 1] : i1[(e & 7) >> 1];
            const int p = __builtin_amdgcn_readfirstlane((int)(short)((e & 1) ? (w >> 16) : (w & 0xffffu)));
            if (p >= 0) {
                const unsigned char* yr = (const unsigned char*)F.YB() + (size_t)(e * EROWS + p) * 1024;
#pragma unroll
                for (int j = 0; j < 4; ++j) q[e][j] = __builtin_nontemporal_load((const unsigned*)(yr + 4 * lane + 256 * j));
            }
        }
#pragma unroll
        for (int e = 0; e < 16; ++e) {
            const unsigned w = (e < 8) ? i0[(e & 7) >> 1] : i1[(e & 7) >> 1];
            const int p = __builtin_amdgcn_readfirstlane((int)(short)((e & 1) ? (w >> 16) : (w & 0xffffu)));
            if (p >= 0) {
#pragma unroll
                for (int j = 0; j < 4; ++j) { const unsigned qq = q[e][j];
                    ys[j][0] += __builtin_amdgcn_cvt_f32_fp8(qq, 0); ys[j][1] += __builtin_amdgcn_cvt_f32_fp8(qq, 1); ys[j][2] += __builtin_amdgcn_cvt_f32_fp8(qq, 2); ys[j][3] += __builtin_amdgcn_cvt_f32_fp8(qq, 3); }
            }
        }
#else
#pragma unroll
        for (int e = 0; e < 16; ++e) {
            const unsigned w = (e < 8) ? i0[(e & 7) >> 1] : i1[(e & 7) >> 1];
            const int p = __builtin_amdgcn_readfirstlane((int)(short)((e & 1) ? (w >> 16) : (w & 0xffffu)));
            if (p >= 0) {
                const bf16_t* yr = F.YB() + (size_t)(e * EROWS + p) * 1024;
#pragma unroll
                for (int j = 0; j < 4; ++j) { const u32x2 q = *(const u32x2*)(yr + 4 * lane + 256 * j);
                    ys[j][0] += bflo(q.x); ys[j][1] += bfhi(q.x); ys[j][2] += bflo(q.y); ys[j][3] += bfhi(q.y); }
            }
        }
#endif
#pragma unroll
        for (int j = 0; j < 4; ++j) v[j] = v[j] + g2[j] * ys[j] * (FFN_FP8 ? (1.0f / 64.0f) : 1.0f);
    }
    if (!fin && l > 0) {
#pragma unroll
        for (int j = 0; j < 4; ++j) { u32x2 w; w.x = pk2(v[j][0], v[j][1]); w.y = pk2(v[j][2], v[j][3]); *(u32x2*)(XBbuf(F) + (size_t)row * D + 4 * lane + 256 * j) = w; }
    }
    float ss = 0.f;
#pragma unroll
    for (int j = 0; j < 4; ++j) ss += (v[j][0] * v[j][0] + v[j][1] * v[j][1]) + (v[j][2] * v[j][2] + v[j][3] * v[j][3]);
    const float rstd = 1.0f / sqrtf(wave_sum(ss, lane) * (1.0f / D) + EPS);
    if (fin) {
#pragma unroll
        for (int j = 0; j < 4; ++j) __builtin_nontemporal_store(v[j] * rstd * gm[j], (f32x4*)(F.out() + (size_t)row * D) + lane + 64 * j);
    } else {
#pragma unroll
        for (int j = 0; j < 4; ++j) {
            const f32x4 h = v[j] * rstd * gm[j] + sh[j];
            u32x2 w; w.x = pk2(h[0], h[1]); w.y = pk2(h[2], h[3]);
            *(u32x2*)(F.H() + (size_t)row * D + 4 * lane + 256 * j) = w;
        }
    }
}
__device__ __forceinline__ void p1_mod(Frame& F, int l, bool fin, int b, f32x4 (&gm)[4], f32x4 (&sh)[4], f32x4 (&g2)[4]) {
    const int lane = F.lane;
#pragma unroll
    for (int j = 0; j < 4; ++j) {
        if (fin) { gm[j] = ((const f32x4*)F.in(17))[lane + 64 * j]; sh[j] = (f32x4){0.f, 0.f, 0.f, 0.f}; }
        else { const float* md = F.MOD() + (size_t)(l * 5 + b) * 6144;
            const f32x4 g = ((const f32x4*)(F.in(6) + l * D))[lane + 64 * j], sc = ((const f32x4*)(md + 1024))[lane + 64 * j];
            gm[j] = g * (sc + 1.0f); sh[j] = ((const f32x4*)md)[lane + 64 * j]; }
        if (l > 0) g2[j] = ((const f32x4*)(F.MOD() + (size_t)((l - 1) * 5 + b) * 6144 + 5 * 1024))[lane + 64 * j];
        else g2[j] = (f32x4){0.f, 0.f, 0.f, 0.f};
    }
}
template <bool XIN>
__device__ __forceinline__ void p1_rows(Frame& F, int l) {
    const bool fin = (l == DEPTH);
    const int lane = F.lane;
    const int gw = F.vcu * NWAVES + F.wave;
    f32x4 gm[4], sh[4], g2[4];
    {
        const int r0 = gw * 8, b = r0 >> 12;
        p1_mod(F, l, fin, b, gm, sh, g2);
        f32x4 v[4], vn[4], yn[4]; u32x4 i0 = (u32x4){0u, 0u, 0u, 0u}, i1 = i0, i0n = i0, i1n = i0;
#pragma unroll
        for (int j = 0; j < 4; ++j) { v[j] = xrow_q<XIN>(xrow_ptr<XIN>(F, r0), lane, j); if (l > 0) v[j] = v[j] + y1_quarter(Y1buf(F) + (size_t)r0 * D, lane, j); }
        if (l > 0) { i0 = *(const u32x4*)(F.INV() + (size_t)r0 * 16); i1 = *(const u32x4*)(F.INV() + (size_t)r0 * 16 + 8); }
#pragma unroll 1
        for (int i = 0; i < 8; ++i) {
            const int row = r0 + i;
            if (i < 7) {
#pragma unroll
                for (int j = 0; j < 4; ++j) { vn[j] = xrow_q<XIN>(xrow_ptr<XIN>(F, row + 1), lane, j); yn[j] = (l > 0) ? y1_quarter(Y1buf(F) + (size_t)(row + 1) * D, lane, j) : (f32x4){0.f, 0.f, 0.f, 0.f}; }
                if (l > 0) { i0n = *(const u32x4*)(F.INV() + (size_t)(row + 1) * 16); i1n = *(const u32x4*)(F.INV() + (size_t)(row + 1) * 16 + 8); }
            }
            p1_one(F, l, fin, row, v, i0, i1, gm, sh, g2);
#pragma unroll
            for (int j = 0; j < 4; ++j) v[j] = vn[j] + yn[j];
            i0 = i0n; i1 = i1n;
        }
    }
    if (!fin && (F.wave & 1) == 0) {
        const int row = NLAT + F.vcu * 4 + (F.wave >> 1);
        p1_mod(F, l, fin, 4, gm, sh, g2);
        f32x4 v[4]; u32x4 i0 = (u32x4){0u, 0u, 0u, 0u}, i1 = i0;
#pragma unroll
        for (int j = 0; j < 4; ++j) { v[j] = xrow_q<XIN>(xrow_ptr<XIN>(F, row), lane, j); if (l > 0) v[j] = v[j] + y1_quarter(Y1buf(F) + (size_t)row * D, lane, j); }
        if (l > 0) { i0 = *(const u32x4*)(F.INV() + (size_t)row * 16); i1 = *(const u32x4*)(F.INV() + (size_t)row * 16 + 8); }
        p1_one(F, l, fin, row, v, i0, i1, gm, sh, g2);
    }
}

template <int NR, bool XIN>
__device__ __forceinline__ void p6_group(Frame& F, int l, int row0, int b, LAS float* wl) {
    const int lane = F.lane;
    const char* xr = xrow_ptr<XIN>(F, row0);
    constexpr size_t XRB = XIN ? (size_t)D * 4 : (size_t)D * 2;
    const bf16_t* yr = Y1buf(F) + (size_t)row0 * D;
    float rstd[NR];
    {
        f32x4 v[NR][4];
#pragma unroll
        for (int r = 0; r < NR; ++r)
#pragma unroll
            for (int j = 0; j < 4; ++j) v[r][j] = xrow_q<XIN>(xr + (size_t)r * XRB, lane, j) + y1_quarter(yr + (size_t)r * D, lane, j);
#pragma unroll
        for (int r = 0; r < NR; ++r) {
            float ss = 0.f;
#pragma unroll
            for (int j = 0; j < 4; ++j) ss += (v[r][j][0] * v[r][j][0] + v[r][j][1] * v[r][j][1]) + (v[r][j][2] * v[r][j][2] + v[r][j][3] * v[r][j][3]);
            rstd[r] = 1.0f / sqrtf(wave_sum(ss, lane) * (1.0f / D) + EPS);
        }
    }
    float acc[NR][16];
#pragma unroll
    for (int r = 0; r < NR; ++r)
#pragma unroll
        for (int e = 0; e < 16; ++e) acc[r][e] = 0.f;
    const float* md = F.MOD() + (size_t)(l * 5 + b) * 6144;
    const float* g2w = F.in(7) + l * D;
    f32x4 cg, csc, csh, cx[NR]; u32x2 cy[NR];
#define P6_LOADQ(j_, g_, sc_, sh_, x_, y_) do { g_ = ((const f32x4*)g2w)[lane + 64 * (j_)]; sc_ = ((const f32x4*)(md + 4096))[lane + 64 * (j_)]; sh_ = ((const f32x4*)(md + 3072))[lane + 64 * (j_)]; \
        _Pragma("unroll") for (int r_ = 0; r_ < NR; ++r_) { x_[r_] = xrow_q<XIN>(xr + (size_t)r_ * XRB, lane, (j_)); y_[r_] = *(const u32x2*)(yr + (size_t)r_ * D + 4 * lane + 256 * (j_)); } } while (0)
    P6_LOADQ(0, cg, csc, csh, cx, cy);
#pragma unroll 1
    for (int j = 0; j < 4; ++j) {
        f32x4 ng = cg, nsc = csc, nsh = csh, nx[NR]; u32x2 ny[NR];
#pragma unroll
        for (int r = 0; r < NR; ++r) { nx[r] = cx[r]; ny[r] = cy[r]; }
        if (j < 3) P6_LOADQ(j + 1, ng, nsc, nsh, nx, ny);
        const f32x4 gmv = cg * (csc + 1.0f), shv = csh;
        f32x4 h[NR];
#pragma unroll
        for (int r = 0; r < NR; ++r) {
            const f32x4 vq = cx[r] + (f32x4){bflo(cy[r].x), bfhi(cy[r].x), bflo(cy[r].y), bfhi(cy[r].y)};
            h[r] = vq * rstd[r] * gmv + shv;
#if FFN_FP8
            *(unsigned*)((unsigned char*)F.H() + (size_t)(row0 + r) * D + 4 * lane + 256 * j) = pk4_fp8(h[r][0], h[r][1], h[r][2], h[r][3]);
#else
            u32x2 w; w.x = pk2(h[r][0], h[r][1]); w.y = pk2(h[r][2], h[r][3]);
            *(u32x2*)(F.H() + (size_t)(row0 + r) * D + 4 * lane + 256 * j) = w;
#endif
        }
#pragma unroll
        for (int i = 0; i < 4; ++i) {
            const LAS f32x4* wp = (const LAS f32x4*)(wl + ((j * 4 + i) * 64 + lane) * 16);
            const f32x4 w0 = wp[0], w1 = wp[1], w2 = wp[2], w3 = wp[3];
#pragma unroll
            for (int r = 0; r < NR; ++r) { const float hv = h[r][i];
                acc[r][0] += hv * w0[0]; acc[r][1] += hv * w0[1]; acc[r][2] += hv * w0[2]; acc[r][3] += hv * w0[3];
                acc[r][4] += hv * w1[0]; acc[r][5] += hv * w1[1]; acc[r][6] += hv * w1[2]; acc[r][7] += hv * w1[3];
                acc[r][8] += hv * w2[0]; acc[r][9] += hv * w2[1]; acc[r][10] += hv * w2[2]; acc[r][11] += hv * w2[3];
                acc[r][12] += hv * w3[0]; acc[r][13] += hv * w3[1]; acc[r][14] += hv * w3[2]; acc[r][15] += hv * w3[3]; }
        }
        cg = ng; csc = nsc; csh = nsh;
#pragma unroll
        for (int r = 0; r < NR; ++r) { cx[r] = nx[r]; cy[r] = ny[r]; }
    }
#undef P6_LOADQ
    const int e = ((lane >> 5) & 1) * 8 + ((lane >> 4) & 1) * 4 + ((lane >> 3) & 1) * 2 + ((lane >> 2) & 1);
    float r8[NR][8], r4[NR][4], r2[NR][2], r1[NR], ex[NR], aff[NR];
#pragma unroll
    for (int r = 0; r < NR; ++r)
#pragma unroll
        for (int i = 0; i < 8; ++i) { const auto p = __builtin_amdgcn_permlane32_swap(__float_as_uint(acc[r][i]), __float_as_uint(acc[r][i + 8]), false, false); r8[r][i] = __uint_as_float(p[0]) + __uint_as_float(p[1]); }
#pragma unroll
    for (int r = 0; r < NR; ++r)
#pragma unroll
        for (int i = 0; i < 4; ++i) { const auto p = __builtin_amdgcn_permlane16_swap(__float_as_uint(r8[r][i]), __float_as_uint(r8[r][i + 4]), false, false); r4[r][i] = __uint_as_float(p[0]) + __uint_as_float(p[1]); }
    { const bool hi = (lane & 8) != 0;
#pragma unroll
      for (int r = 0; r < NR; ++r)
#pragma unroll
          for (int i = 0; i < 2; ++i) { const float keep = hi ? r4[r][i + 2] : r4[r][i], send = hi ? r4[r][i] : r4[r][i + 2]; r2[r][i] = keep + shx(send, 8, lane); } }
    { const bool hi = (lane & 4) != 0;
#pragma unroll
      for (int r = 0; r < NR; ++r) { const float keep = hi ? r2[r][1] : r2[r][0], send = hi ? r2[r][0] : r2[r][1]; r1[r] = keep + shx(send, 4, lane); } }
#pragma unroll
    for (int r = 0; r < NR; ++r) r1[r] += shx(r1[r], 2, lane);
#pragma unroll
    for (int r = 0; r < NR; ++r) r1[r] += shx(r1[r], 1, lane);
    {
        float mx[NR], sm[NR];
#pragma unroll
        for (int r = 0; r < NR; ++r) mx[r] = fmaxf(r1[r], shx(r1[r], 4, lane));
#pragma unroll
        for (int r = 0; r < NR; ++r) mx[r] = fmaxf(mx[r], shx(mx[r], 8, lane));
#pragma unroll
        for (int r = 0; r < NR; ++r) mx[r] = max_x16(mx[r]);
#pragma unroll
        for (int r = 0; r < NR; ++r) mx[r] = max_x32(mx[r]);
#pragma unroll
        for (int r = 0; r < NR; ++r) { ex[r] = __expf(r1[r] - mx[r]); sm[r] = ex[r] + shx(ex[r], 4, lane); }
#pragma unroll
        for (int r = 0; r < NR; ++r) sm[r] += shx(sm[r], 8, lane);
#pragma unroll
        for (int r = 0; r < NR; ++r) sm[r] = sum_x16(sm[r]);
#pragma unroll
        for (int r = 0; r < NR; ++r) { sm[r] = sum_x32(sm[r]); aff[r] = ex[r] / sm[r]; }
    }
    if ((lane & 3) == 0) {
        if constexpr (NR == 4) {
            const f32x4 a4 = (f32x4){aff[0], aff[1], aff[2], aff[3]};
            if (row0 < NLAT) *(f32x4*)(F.AFF() + (size_t)(b * NE + e) * SEQ + (row0 & (SEQ - 1))) = a4;
            else { const int rc = row0 - NLAT; *(f32x4*)(F.AFF() + (size_t)BATCH * NE * SEQ + (size_t)((rc >> 8) * NE + e) * CTXL + (rc & 255)) = a4; }
        } else {
#pragma unroll
            for (int r = 0; r < NR; ++r) {
                const int row = row0 + r;
                if (row < NLAT) F.AFF()[(size_t)(b * NE + e) * SEQ + (row & (SEQ - 1))] = aff[r];
                else { const int rc = row - NLAT; F.AFF()[(size_t)BATCH * NE * SEQ + (size_t)((rc >> 8) * NE + e) * CTXL + (rc & 255)] = aff[r]; }
            }
        }
    }
}
template <bool XIN>
__device__ __forceinline__ void p6_rows(Frame& F0, int l, unsigned* cnt5) {
    Frame F = F0; asm volatile("" : "+v"(F.lane), "+v"(F.tid), "+s"(F.vcu), "+s"(F.wave));
    LAS float* wl = (LAS float*)F.lds;
    {
        const f32x4* wsrc = (const f32x4*)(F.in(13) + (size_t)l * 1024 * 16);
        f32x4 t[8];
#pragma unroll
        for (int i = 0; i < 8; ++i) t[i] = wsrc[F.tid + NTHREADS * i];
#pragma unroll
        for (int i = 0; i < 8; ++i) { const int c = F.tid + NTHREADS * i, k = c >> 2, e0 = (c & 3) * 4;
            *(LAS f32x4*)(wl + (((k >> 8) * 4 + (k & 3)) * 64 + ((k >> 2) & 63)) * 16 + e0) = t[i]; }
    }
    __syncthreads();
    const int gw = F.vcu * NWAVES + F.wave;
    {
        const int r0 = gw * 8, b = r0 >> 12;
        wait_counter<false>(cnt5 + 64 * (F.vcu >> 2), 32u, F.tid);
#pragma unroll 1
        for (int gi = 0; gi < 2; ++gi) p6_group<4, XIN>(F, l, r0 + 4 * gi, b, wl);
    }
    if (l != DEPTH - 1) {
        wait_counter<false>(cnt5 + 64 * (64 + (F.vcu >> 2)), 32u, F.tid);
        if ((F.wave & 1) == 0) p6_group<1, XIN>(F, l, NLAT + F.vcu * 4 + (F.wave >> 1), 4, wl);
    }
}

__device__ __forceinline__ void p5_ctx_piece(Frame& F, int l, unsigned* cnt5) {
    const int lane = F.lane, fr = lane & 15, fq = lane >> 4;
    const int g = F.vcu >> 2, cq = F.vcu & 3;
    const int row0 = NLAT + 16 * g;
    const int n0 = 256 * cq + 32 * F.wave;
    const bf16_t* ap = F.MIX() + (size_t)(row0 + fr) * D + 8 * fq;
    const bf16_t* bp = F.WOUT() + (size_t)l * 1024 * 1024 + (size_t)(n0 + fr) * 1024 + 8 * fq;
    f32x4 acc0 = (f32x4){0.f, 0.f, 0.f, 0.f}, acc1 = acc0;
#pragma unroll 1
    for (int s0 = 0; s0 < 32; s0 += 16) {
        bf16x8 a[16], b0[16], b1[16];
#pragma unroll
        for (int k = 0; k < 16; ++k) { a[k] = *(const bf16x8*)(ap + 32 * (s0 + k)); b0[k] = *(const bf16x8*)(bp + 32 * (s0 + k)); b1[k] = *(const bf16x8*)(bp + 16 * 1024 + 32 * (s0 + k)); }
#pragma unroll
        for (int k = 0; k < 16; ++k) { acc0 = __builtin_amdgcn_mfma_f32_16x16x32_bf16(a[k], b0[k], acc0, 0, 0, 0); acc1 = __builtin_amdgcn_mfma_f32_16x16x32_bf16(a[k], b1[k], acc1, 0, 0, 0); }
    }
    const float* g1 = F.MOD() + (size_t)(l * 5 + 4) * 6144 + 2048;
    bf16_t* yo = Y1buf(F) + (size_t)row0 * D;
#pragma unroll
    for (int t = 0; t < 2; ++t) {
        const int col = n0 + 16 * t + fr; const float gg = g1[col];
#pragma unroll
        for (int r = 0; r < 4; ++r) { const int rr = 4 * fq + r; const float v = gg * (t == 0 ? acc0[r] : acc1[r]);
            __hip_atomic_store(yo + (size_t)rr * D + col, (bf16_t)(pk2(v, 0.f) & 0xffffu), __ATOMIC_RELAXED, __HIP_MEMORY_SCOPE_AGENT); }
    }
    asm volatile("s_waitcnt vmcnt(0)" ::: "memory");
    arrive_counter(cnt5 + 64 * (64 + g), lane);
}

__device__ __forceinline__ int wave_isum(int v, int lane) {
    v += shxi(v, 1, lane); v += shxi(v, 2, lane); v += shxi(v, 4, lane); v += shxi(v, 8, lane);
    { const auto p = __builtin_amdgcn_permlane16_swap((unsigned)v, (unsigned)v, false, false); v = (int)(p[0] + p[1]); }
    { const auto p = __builtin_amdgcn_permlane32_swap((unsigned)v, (unsigned)v, false, false); v = (int)(p[0] + p[1]); }
    return v;
}
__device__ __forceinline__ void p7_topk(Frame& F, int l) {
    LAS int* cnts = (LAS int*)F.lds;
    const int nprob = (l == DEPTH - 1) ? 64 : 128;
    const int tid = F.tid, lane = F.lane, wave = F.wave;
    for (int prob = F.bid; prob < nprob; prob += F.G) {
        const bool isc = prob >= 64; const int pb = prob & 63; const int b = pb >> 4, e = pb & 15;
        const int n = isc ? CTXL : SEQ, KSEL = isc ? CAP_C : CAP_L;
        const float* aff = isc ? F.AFF() + (size_t)BATCH * NE * SEQ + (size_t)(b * NE + e) * CTXL : F.AFF() + (size_t)(b * NE + e) * SEQ;
        unsigned key[8];
        if (tid * 8 < n) { const u32x4 k0 = *(const u32x4*)(aff + tid * 8), k1 = *(const u32x4*)(aff + tid * 8 + 4);
            key[0] = k0.x; key[1] = k0.y; key[2] = k0.z; key[3] = k0.w; key[4] = k1.x; key[5] = k1.y; key[6] = k1.z; key[7] = k1.w; }
        else {
#pragma unroll
            for (int i = 0; i < 8; ++i) key[i] = 0u;
        }
        unsigned prefix = 0u; int krem = KSEL;
        LAS int* hist = (LAS int*)(F.lds + 1024);
        LAS int* wtot = (LAS int*)(F.lds + 512);
#pragma unroll 1
        for (int pass = 0; pass < 3; ++pass) {
            const int shift = pass == 0 ? 19 : (pass == 1 ? 7 : 0), nbits = pass == 2 ? 7 : 12, hshift = shift + nbits;
            const int nb = 1 << nbits;
#pragma unroll
            for (int i = 0; i < 8; ++i) hist[tid * 8 + i] = 0;
            __syncthreads();
#pragma unroll
            for (int i = 0; i < 8; ++i) { const unsigned k = key[i]; if (k != 0u && (k >> hshift) == prefix) __hip_atomic_fetch_add(hist + ((k >> shift) & (unsigned)(nb - 1)), 1, __ATOMIC_RELAXED, __HIP_MEMORY_SCOPE_WORKGROUP); }
            __syncthreads();
            int hb[8]; int ssum = 0;
#pragma unroll
            for (int i = 0; i < 8; ++i) { hb[i] = hist[tid * 8 + i]; ssum += hb[i]; }
            int suf = ssum;
#pragma unroll
            for (int o = 1; o < 64; o <<= 1) { const int t = __builtin_amdgcn_ds_bpermute(((lane + o) & 63) << 2, suf); if (lane + o < 64) suf += t; }
            if (lane == 0) wtot[wave] = suf;
            __syncthreads();
            int above_w = 0;
#pragma unroll
            for (int w = 0; w < 8; ++w) { const int t = wtot[w]; if (w > wave) above_w += t; }
            const int incl = above_w + suf, excl = incl - ssum;
            if (excl < krem && krem <= incl) {
                int run = excl, dig = 0, cab = 0;
#pragma unroll
                for (int i = 7; i >= 0; --i) { if (run < krem && krem <= run + hb[i]) { dig = tid * 8 + i; cab = run; } run += hb[i]; }
                wtot[8] = dig; wtot[9] = cab;
            }
            __syncthreads();
            prefix = (prefix << nbits) | (unsigned)wtot[8]; krem -= wtot[9];
        }
        const unsigned T = prefix;
        int g = 0, q = 0;
#pragma unroll
        for (int i = 0; i < 8; ++i) { g += (key[i] > T) ? 1 : 0; q += (key[i] == T) ? 1 : 0; }
        int pack = g | (q << 16), incl = pack;
#pragma unroll
        for (int o = 1; o < 64; o <<= 1) { const int t = __builtin_amdgcn_ds_bpermute(((lane - o) & 63) << 2, incl); if (lane >= o) incl += t; }
        if (lane == 63) cnts[16 + wave] = incl;
        __syncthreads();
        int wpre = 0, total = 0;
#pragma unroll
        for (int w = 0; w < 8; ++w) { const int t = cnts[16 + w]; total += t; if (w < wave) wpre += t; }
        const int excl = wpre + incl - pack;
        int g_run = excl & 0xffff, q_run = excl >> 16;
        const int need = KSEL - (total & 0xffff);
        const int posbase = isc ? (4 * CAP_L + b * CAP_C) : b * CAP_L;
        const int rowbase = isc ? NLAT + b * CTXL : b * SEQ;
        if (tid * 8 < n) {
#pragma unroll
            for (int i = 0; i < 8; ++i) {
                const int token = tid * 8 + i; int slot = -1;
                if (key[i] > T) { slot = g_run + (q_run < need ? q_run : need); ++g_run; }
                else if (key[i] == T) { if (q_run < need) slot = g_run + q_run; ++q_run; }
                F.INV()[(size_t)(rowbase + token) * 16 + e] = (short)(slot >= 0 ? posbase + slot : -1);
                if (slot >= 0) { F.ROWS()[e * EROWS + posbase + slot] = rowbase + token; F.GATE()[e * EROWS + posbase + slot] = __uint_as_float(key[i]); }
            }
        }
        if (!isc && b == 0 && tid < 128) { F.ROWS()[e * EROWS + 2176 + tid] = 0; F.GATE()[e * EROWS + 2176 + tid] = 0.f; }
        __syncthreads();
    }
}

__device__ __forceinline__ float log_gamma(const Frame& F, int l, int dir, int h) {
    const float x = F.in(10)[(l * 2 + dir) * 4 + h];
    return -log1pf(__expf(-x));
}
__device__ __forceinline__ void p3_conv(Frame& F, int l, const int gw, const int NGW) {
    const int nrows = (l == DEPTH - 1) ? NLAT : MROWS;
    const int c = 4 * F.lane;
    const f32x4 w0 = *(const f32x4*)(F.in(9) + (l * 3 + 0) * 256 + c), w1 = *(const f32x4*)(F.in(9) + (l * 3 + 1) * 256 + c), w2 = *(const f32x4*)(F.in(9) + (l * 3 + 2) * 256 + c);
    for (int r0 = gw * 4; r0 < nrows; r0 += NGW * 4) {
        int t0, len; if (r0 < NLAT) { t0 = r0 & (SEQ - 1); len = SEQ; } else { t0 = (r0 - NLAT) & (CTXL - 1); len = CTXL; }
        const bf16_t* p = F.PROJ() + (size_t)r0 * INW + c;
        u32x2 ca[6], gb[4];
#pragma unroll
        for (int d = 0; d < 6; ++d) { const int tt = t0 + d - 1; const bool ok = (tt >= 0 && tt < len); const bf16_t* pp = p + (ptrdiff_t)(ok ? d - 1 : 0) * INW;
            ca[d] = *(const u32x2*)(pp + C_CC); if (!ok) { ca[d] = (u32x2){0u, 0u}; } }
#pragma unroll
        for (int d = 0; d < 4; ++d) gb[d] = *(const u32x2*)(p + (size_t)d * INW + C_CB);
        f32x4 z[6];
#pragma unroll
        for (int d = 0; d < 6; ++d) z[d] = (f32x4){bflo(ca[d].x), bfhi(ca[d].x), bflo(ca[d].y), bfhi(ca[d].y)};
#pragma unroll
        for (int d = 0; d < 4; ++d) {
            const f32x4 cv = z[d] * w0 + z[d + 1] * w1 + z[d + 2] * w2;
            const f32x4 o = (f32x4){bflo(gb[d].x), bfhi(gb[d].x), bflo(gb[d].y), bfhi(gb[d].y)} * cv;
            u32x2 w; w.x = pk2(o[0], o[1]); w.y = pk2(o[2], o[3]);
            *(u32x2*)(F.MIX() + (size_t)(r0 + d) * D + c) = w;
        }
    }
}
__device__ __forceinline__ int chunk_row0(int b, int u) { return u < 2 ? NLAT + b * CTXL + u * 128 : b * SEQ + (u - 2) * 128; }
struct UsLoad { u32x4 kq[2], vq[2]; };
__device__ __forceinline__ void p3_ustate_load(Frame& F, int b, int h, int u, UsLoad& L) {
    const int row0 = chunk_row0(b, u);
#pragma unroll
    for (int r = 0; r < 2; ++r) {
        const int idx = F.tid + r * NTHREADS, tok = idx >> 3, c = idx & 7;
        const bf16_t* p = F.PROJ() + (size_t)(row0 + tok) * INW + h * 64 + 8 * c;
        L.kq[r] = *(const u32x4*)(p + C_RK); L.vq[r] = *(const u32x4*)(p + C_RV);
    }
}
typedef short v4i16_t __attribute__((ext_vector_type(4)));
__device__ __forceinline__ bf16x8 tr_frag(const LAS unsigned char* img, int pitch, int r0, int c0, int lane) {
    const int i = lane & 15, g = lane >> 4;
    const LAS unsigned char* p = img + (r0 + 8 * g + (i >> 2)) * pitch + (c0 + 4 * (i & 3)) * 2;
    const v4i16_t lo = __builtin_amdgcn_ds_read_tr16_b64_v4i16((LAS v4i16_t*)p), hi = __builtin_amdgcn_ds_read_tr16_b64_v4i16((LAS v4i16_t*)(p + 4 * pitch));
    return (bf16x8){lo[0], lo[1], lo[2], lo[3], hi[0], hi[1], hi[2], hi[3]};
}
__device__ __forceinline__ void p3_ustate_stage(Frame& F, int l, int h, const UsLoad& L) {
    constexpr int PT = 144;
    LAS unsigned char* Kf = F.lds; LAS unsigned char* Kb = F.lds + 128 * PT; LAS unsigned char* Vs = F.lds + 256 * PT;
    const float lgf = log_gamma(F, l, 0, h) * LOG2E, lgb = log_gamma(F, l, 1, h) * LOG2E;
#pragma unroll
    for (int r = 0; r < 2; ++r) {
        const int idx = F.tid + r * NTHREADS, tok = idx >> 3, c = idx & 7;
        const float wf = fexp2(lgf * (float)(127 - tok)), wb = fexp2(lgb * (float)tok);
        u32x4 kf, kb;
#pragma unroll
        for (int i = 0; i < 4; ++i) { const unsigned kw = L.kq[r][i]; const float k0 = bflo(kw), k1 = bfhi(kw); kf[i] = pk2(k0 * wf, k1 * wf); kb[i] = pk2(k0 * wb, k1 * wb); }
        *(LAS u32x4*)(Kf + tok * PT + c * 16) = kf; *(LAS u32x4*)(Kb + tok * PT + c * 16) = kb; *(LAS u32x4*)(Vs + tok * PT + c * 16) = L.vq[r];
    }
}
__device__ __forceinline__ void p3_ustate_mma(Frame& F, int b, int h, int u) {
    constexpr int PT = 144;
    LAS unsigned char* Kf = F.lds; LAS unsigned char* Kb = F.lds + 128 * PT; LAS unsigned char* Vs = F.lds + 256 * PT;
    const int fr = F.lane & 15, fq = F.lane >> 4, dkt = F.wave >> 1;
#pragma unroll
    for (int dir = 0; dir < 2; ++dir) {
        LAS unsigned char* Ks = dir ? Kb : Kf;
#pragma unroll
        for (int dd = 0; dd < 2; ++dd) {
            const int dvt = (F.wave & 1) * 2 + dd;
            f32x4 acc = (f32x4){0.f, 0.f, 0.f, 0.f};
#pragma unroll
            for (int s = 0; s < 4; ++s) {
                const bf16x8 af = tr_frag(Ks, PT, 32 * s, dkt * 16, F.lane);
                const bf16x8 bf = tr_frag(Vs, PT, 32 * s, dvt * 16, F.lane);
                acc = __builtin_amdgcn_mfma_f32_16x16x32_bf16(af, bf, acc, 0, 0, 0);
            }
            float* up = F.U() + ((size_t)(((dir * BATCH + b) * 4 + h) * NCHUNK + u)) * 4096 + (dvt * 16 + fr) * 64 + dkt * 16 + 4 * fq;
            *(f32x4*)up = acc;
        }
    }
}
__device__ __forceinline__ void p3_ustates(Frame& F, int l, int first, int stride) {
    constexpr int NIT = BATCH * 4 * NCHUNK;
    if (first >= NIT) return;
    UsLoad L;
    p3_ustate_load(F, (first / NCHUNK) >> 2, (first / NCHUNK) & 3, first % NCHUNK, L);
    for (int it = first; it < NIT; it += stride) {
        const int u = it % NCHUNK, bh = it / NCHUNK;
        __syncthreads();
        p3_ustate_stage(F, l, bh & 3, L);
        __syncthreads();
        const int nx = it + stride;
        if (nx < NIT) p3_ustate_load(F, (nx / NCHUNK) >> 2, (nx / NCHUNK) & 3, nx % NCHUNK, L);
        p3_ustate_mma(F, bh >> 2, bh & 3, u);
    }
}
typedef float f32x16 __attribute__((ext_vector_type(16)));
#ifndef ATT_THR
#define ATT_THR 5.0f
#endif
__device__ __forceinline__ int crow(int reg, int h) { return (reg & 3) + 8 * (reg >> 2) + 4 * h; }
__device__ __forceinline__ void p3_attn_item(Frame& F, int l, int b, int kvh, int qb, bool is_ctx) {
    constexpr int PK = 144, PV = 136, BUF = 64 * PK + 64 * PV;
    const int lane = F.lane, r = lane & 31, h = lane >> 5, g = F.wave >> 1, hw = F.wave & 1, hq = kvh * 4 + g;
    const int tq0 = qb * 128 + hw * 64;
    const int qrow0 = is_ctx ? NLAT + b * CTXL + tq0 : b * SEQ + tq0;
    bf16x8 qf[2][4];
#pragma unroll
    for (int qt = 0; qt < 2; ++qt)
#pragma unroll
        for (int s = 0; s < 4; ++s) qf[qt][s] = *(const bf16x8*)(F.PROJ() + (size_t)(qrow0 + qt * 32 + r) * INW + C_AQ + hq * 64 + 16 * s + 8 * h);
    f32x16 o[2][2];
#pragma unroll
    for (int dt = 0; dt < 2; ++dt)
#pragma unroll
        for (int qt = 0; qt < 2; ++qt)
#pragma unroll
            for (int i = 0; i < 16; ++i) o[dt][qt][i] = 0.f;
    float mrun[2], lrun[2];
    const float sink = F.in(11)[l * 8 + hq];
#pragma unroll
    for (int qt = 0; qt < 2; ++qt) { mrun[qt] = sink; lrun[qt] = (h == 0) ? 1.0f : 0.0f; }
    const int ti0 = (!is_ctx && qb == 0) ? 2 : 0;
    const int nwin = is_ctx ? 0 : 6 - ti0 - ((qb == SEQ / 128 - 1) ? 2 : 0);
    const int ntile = nwin + 4;
    const int skey = F.tid >> 3, sc = F.tid & 7;
    u32x4 kq, vq;
#define ATT_ROWBASE(i) ((i) < nwin ? b * SEQ + qb * 128 - 128 + 64 * (ti0 + (i)) : NLAT + b * CTXL + 64 * ((i) - nwin))
#define ATT_LOAD(i) do { const bf16_t* p_ = F.PROJ() + (size_t)(ATT_ROWBASE(i) + skey) * INW + kvh * 64 + 8 * sc; kq = *(const u32x4*)(p_ + C_AK); vq = *(const u32x4*)(p_ + C_AV); } while (0)
#define ATT_STORE(buf) do { LAS unsigned char* Ks_ = F.lds + (buf) * BUF; LAS unsigned char* Vt_ = Ks_ + 64 * PK; \
        *(LAS u32x4*)(Ks_ + skey * PK + sc * 16) = kq; \
        _Pragma("unroll") for (int i_ = 0; i_ < 4; ++i_) { const unsigned vw_ = vq[i_]; \
            *(LAS bf16_t*)(Vt_ + (8 * sc + 2 * i_) * PV + skey * 2) = (bf16_t)(vw_ & 0xffffu); *(LAS bf16_t*)(Vt_ + (8 * sc + 2 * i_ + 1) * PV + skey * 2) = (bf16_t)(vw_ >> 16); } } while (0)
    ATT_LOAD(0);
    __syncthreads();
    ATT_STORE(0);
    if (F.wave < 4) __builtin_amdgcn_s_setprio(2); else __builtin_amdgcn_s_setprio(0);
    int cur = 0;
    for (int it = 0; it < ntile; ++it) {
        __syncthreads();
        if (it + 1 < ntile) ATT_LOAD(it + 1);
        const bool win = it < nwin;
        const int ti = ti0 + it;
        const bool part = win ? (hw == 0 ? ti <= 4 : ti >= 1) : true;
        if (part) {
            const LAS unsigned char* Ks = F.lds + cur * BUF; const LAS unsigned char* Vt = Ks + 64 * PK;
            const bool mask = win && (hw == 0 ? (ti == 0 || ti == 4) : (ti == 1 || ti == 5));
            const int tk = qb * 128 - 128 + 64 * ti;
#pragma unroll
            for (int qt = 0; qt < 2; ++qt) {
                f32x16 st[2];
#pragma unroll
                for (int kt = 0; kt < 2; ++kt) {
#pragma unroll
                    for (int i = 0; i < 16; ++i) st[kt][i] = 0.f;
#pragma unroll
                    for (int s = 0; s < 4; ++s) { const bf16x8 kf = *(const LAS bf16x8*)(Ks + (kt * 32 + r) * PK + (16 * s + 8 * h) * 2); st[kt] = __builtin_amdgcn_mfma_f32_32x32x16_bf16(kf, qf[qt][s], st[kt], 0, 0, 0); }
                }
                if (mask) {
#pragma unroll
                    for (int kt = 0; kt < 2; ++kt)
#pragma unroll
                        for (int i = 0; i < 16; ++i) { const int dlt = (tq0 + qt * 32 + r) - (tk + kt * 32 + crow(i, h)); if (dlt > 128 || dlt < -128) st[kt][i] = -INFINITY; }
                }
                float mx = st[0][0];
#pragma unroll
                for (int kt = 0; kt < 2; ++kt)
#pragma unroll
                    for (int i = 0; i < 16; ++i) mx = fmaxf(mx, st[kt][i]);
                mx = max_x32(mx);
                float alpha = 1.0f;
                const bool resc = !__all(mx - mrun[qt] <= ATT_THR);
                if (resc) { const float mnew = fmaxf(mrun[qt], mx); alpha = fexp(mrun[qt] - mnew); mrun[qt] = mnew; }
                const float mneg = -mrun[qt] * LOG2E;
                float ps = 0.f;
                bf16x8 pb[2][2];
#pragma unroll
                for (int kt = 0; kt < 2; ++kt)
#pragma unroll
                    for (int s = 0; s < 2; ++s) {
                        float e[8];
#pragma unroll
                        for (int j = 0; j < 8; ++j) { e[j] = fexp2(st[kt][8 * s + j] * LOG2E + mneg); ps += e[j]; }
                        u32x4 w; w.x = pk2(e[0], e[1]); w.y = pk2(e[2], e[3]); w.z = pk2(e[4], e[5]); w.w = pk2(e[6], e[7]);
                        pb[kt][s] = __builtin_bit_cast(bf16x8, w);
                    }
                lrun[qt] = lrun[qt] * alpha + ps;
#pragma unroll
                for (int dt = 0; dt < 2; ++dt) {
                    if (resc) {
#pragma unroll
                        for (int i = 0; i < 16; ++i) o[dt][qt][i] *= alpha;
                    }
#pragma unroll
                    for (int kt = 0; kt < 2; ++kt)
#pragma unroll
                        for (int s = 0; s < 2; ++s) {
                            const LAS unsigned char* vp = Vt + (dt * 32 + r) * PV + (kt * 32 + 16 * s + 4 * h) * 2;
                            const u32x2 v0 = *(const LAS u32x2*)vp, v1 = *(const LAS u32x2*)(vp + 16);
                            u32x4 vw; vw.x = v0.x; vw.y = v0.y; vw.z = v1.x; vw.w = v1.y;
                            o[dt][qt] = __builtin_amdgcn_mfma_f32_32x32x16_bf16(__builtin_bit_cast(bf16x8, vw), pb[kt][s], o[dt][qt], 0, 0, 0);
                        }
                }
                __builtin_amdgcn_sched_barrier(0);
            }
        }
        if (it + 1 < ntile) ATT_STORE(cur ^ 1);
        cur ^= 1;
    }
    __builtin_amdgcn_s_setprio(0);
#pragma unroll
    for (int qt = 0; qt < 2; ++qt) {
        const float inv = 1.0f / sum_x32(lrun[qt]);
        bf16_t* op = F.MIX() + (size_t)(qrow0 + qt * 32 + r) * D + 512 + hq * 64 + 4 * h;
#pragma unroll
        for (int dt = 0; dt < 2; ++dt)
#pragma unroll
            for (int g4 = 0; g4 < 4; ++g4) { u32x2 w; w.x = pk2(o[dt][qt][4 * g4] * inv, o[dt][qt][4 * g4 + 1] * inv); w.y = pk2(o[dt][qt][4 * g4 + 2] * inv, o[dt][qt][4 * g4 + 3] * inv);
                *(u32x2*)(op + dt * 32 + 8 * g4) = w; }
    }
#undef ATT_ROWBASE
#undef ATT_LOAD
#undef ATT_STORE
}
#ifndef ATT_REP
#define ATT_REP 1
#endif
#ifndef UST_REP
#define UST_REP 1
#endif
#ifndef CONV_REP
#define CONV_REP 1
#endif
__device__ __forceinline__ void p3_mix(Frame& F, int l) {
    const bool lastl = (l == DEPTH - 1);
    const int nlight = lastl ? 0 : 16;
    const int lb = F.bid - nlight, nl = F.G - nlight;
    if (F.bid >= nlight) {
        for (int rr = 0; rr < UST_REP; ++rr) p3_ustates(F, l, lb, nl);
        __syncthreads();
    }
    for (int rr = 0; rr < ATT_REP; ++rr) { const int it = F.vcu  ; const int b = it >> 6, kvh = (it >> 5) & 1, qb = it & 31; p3_attn_item(F, l, b, kvh, qb, false); }
    if (F.bid < nlight) { const int j = F.bid; p3_attn_item(F, l, j >> 2, (j >> 1) & 1, j & 1, true); }
    else if (lastl) {
        for (int rr = 0; rr < CONV_REP; ++rr)
        p3_conv(F, l, lb * NWAVES + F.wave, nl * NWAVES);
    }
}

__device__ __forceinline__ void p3b_scan(Frame& F, int l) {
    for (int idx = F.bid * NTHREADS + F.tid; idx < 2 * BATCH * 4 * 4096; idx += F.G * NTHREADS) {
        const int dir = idx >> 16, rem = idx & 65535, bh = rem >> 12, el = rem & 4095;
        const float dec = fexp2(log_gamma(F, l, dir, bh & 3) * LOG2E * 128.0f);
        const float* up = F.U() + (size_t)((dir * 16 + bh) * NCHUNK) * 4096 + el;
        bf16_t* sp = F.ST() + (size_t)((dir * 16 + bh) * NCHUNK) * 4096 + el;
        float uv[NCHUNK];
#pragma unroll
        for (int u = 0; u < NCHUNK; ++u) uv[u] = up[(size_t)u * 4096];
        float s = 0.f;
        if (dir == 0) {
#pragma unroll
            for (int u = 0; u < NCHUNK; ++u) { sp[(size_t)u * 4096] = (bf16_t)(pk2(s, 0.f) & 0xffffu); s = dec * s + uv[u]; }
        } else {
            sp[(size_t)1 * 4096] = (bf16_t)(pk2(s, 0.f) & 0xffffu); s = dec * s + uv[1];
            sp[(size_t)0 * 4096] = (bf16_t)(pk2(s, 0.f) & 0xffffu); s = dec * s + uv[0];
#pragma unroll
            for (int u = NCHUNK - 1; u >= 2; --u) { sp[(size_t)u * 4096] = (bf16_t)(pk2(s, 0.f) & 0xffffu); s = dec * s + uv[u]; }
        }
    }
}

__device__ __forceinline__ void p4_ret_item(Frame& F, int l, int b, int h, int u) {
    constexpr int PK = 144, PT = 272;
    LAS unsigned char* Ks = F.lds; LAS unsigned char* Vs = F.lds + 128 * PK; LAS unsigned char* Pw = F.lds + 256 * PK + F.wave * (16 * PT);
    const int lane = F.lane, fr = lane & 15, fq = lane >> 4;
    const int row0 = chunk_row0(b, u);
    const int qi = F.wave * 16 + fr;
    const int qrow = row0 + qi;
    u32x4 kq[2], vq[2];
#pragma unroll
    for (int r = 0; r < 2; ++r) {
        const int idx = F.tid + r * NTHREADS, tok = idx >> 3, c = idx & 7;
        const bf16_t* p = F.PROJ() + (size_t)(row0 + tok) * INW + h * 64 + 8 * c;
        kq[r] = *(const u32x4*)(p + C_RK); vq[r] = *(const u32x4*)(p + C_RV);
    }
    bf16x8 qf[2];
#pragma unroll
    for (int s = 0; s < 2; ++s) qf[s] = *(const bf16x8*)(F.PROJ() + (size_t)qrow * INW + C_RQ + h * 64 + 32 * s + 8 * fq);
    u32x2 gq[2][4]; bf16x8 sf[2][2][4];
#pragma unroll
    for (int dir = 0; dir < 2; ++dir) {
        const bf16_t* gp = F.PROJ() + (size_t)qrow * INW + (dir == 0 ? C_RGF : C_RGB) + h * 64 + 4 * fq;
        const bf16_t* stp = F.ST() + (size_t)(((dir * BATCH + b) * 4 + h) * NCHUNK + u) * 4096;
#pragma unroll
        for (int dt = 0; dt < 4; ++dt) { gq[dir][dt] = *(const u32x2*)(gp + dt * 16);
#pragma unroll
            for (int s = 0; s < 2; ++s) sf[dir][s][dt] = *(const bf16x8*)(stp + (dt * 16 + fr) * 64 + 32 * s + 8 * fq); }
    }
    __syncthreads();
#pragma unroll
    for (int r = 0; r < 2; ++r) {
        const int idx = F.tid + r * NTHREADS, tok = idx >> 3, c = idx & 7;
        *(LAS u32x4*)(Ks + tok * PK + c * 16) = kq[r]; *(LAS u32x4*)(Vs + tok * PK + c * 16) = vq[r];
    }
    __syncthreads();
    f32x4 st[8];
#pragma unroll
    for (int kt = 0; kt < 8; ++kt) {
        const bf16x8 k0 = *(const LAS bf16x8*)(Ks + (kt * 16 + fr) * PK + (8 * fq) * 2), k1 = *(const LAS bf16x8*)(Ks + (kt * 16 + fr) * PK + (32 + 8 * fq) * 2);
        f32x4 z = (f32x4){0.f, 0.f, 0.f, 0.f};
        z = __builtin_amdgcn_mfma_f32_16x16x32_bf16(k0, qf[0], z, 0, 0, 0);
        st[kt] = __builtin_amdgcn_mfma_f32_16x16x32_bf16(k1, qf[1], z, 0, 0, 0);
    }
    f32x4 res[4];
#pragma unroll
    for (int dt = 0; dt < 4; ++dt) res[dt] = (f32x4){0.f, 0.f, 0.f, 0.f};
#pragma unroll
    for (int dir = 0; dir < 2; ++dir) {
        const float lg2 = log_gamma(F, l, dir, h) * LOG2E;
#pragma unroll
        for (int kt = 0; kt < 8; ++kt) {
            f32x4 p;
#pragma unroll
            for (int r = 0; r < 4; ++r) { const int j = kt * 16 + 4 * fq + r; const int df = dir == 0 ? qi - j : j - qi; p[r] = df >= 0 ? st[kt][r] * fexp2(lg2 * (float)df) : 0.f; }
            u32x2 w; w.x = pk2(p[0], p[1]); w.y = pk2(p[2], p[3]);
            *(LAS u32x2*)(Pw + fr * PT + (kt * 16 + 4 * fq) * 2) = w;
        }
        f32x4 o[4];
#pragma unroll
        for (int dt = 0; dt < 4; ++dt) o[dt] = (f32x4){0.f, 0.f, 0.f, 0.f};
#pragma unroll
        for (int s = 0; s < 4; ++s) {
            const bf16x8 pf = *(const LAS bf16x8*)(Pw + fr * PT + (32 * s + 8 * fq) * 2);
#pragma unroll
            for (int dt = 0; dt < 4; ++dt) { const bf16x8 vf = tr_frag(Vs, PK, 32 * s, dt * 16, lane); o[dt] = __builtin_amdgcn_mfma_f32_16x16x32_bf16(vf, pf, o[dt], 0, 0, 0); }
        }
        f32x4 tt[4];
#pragma unroll
        for (int dt = 0; dt < 4; ++dt) tt[dt] = (f32x4){0.f, 0.f, 0.f, 0.f};
#pragma unroll
        for (int s = 0; s < 2; ++s)
#pragma unroll
            for (int dt = 0; dt < 4; ++dt) tt[dt] = __builtin_amdgcn_mfma_f32_16x16x32_bf16(sf[dir][s][dt], qf[s], tt[dt], 0, 0, 0);
        const float qdec = fexp2(lg2 * (float)(dir == 0 ? qi + 1 : 128 - qi));
        float sm = 0.f;
#pragma unroll
        for (int dt = 0; dt < 4; ++dt) { o[dt] = o[dt] + tt[dt] * qdec; sm += (o[dt][0] + o[dt][1]) + (o[dt][2] + o[dt][3]); }
        sm = sum_x16(sm); sm = sum_x32(sm);
        const float mean = sm * (1.0f / 64.0f);
        float vr = 0.f;
#pragma unroll
        for (int dt = 0; dt < 4; ++dt) { o[dt] = o[dt] - mean; vr += (o[dt][0] * o[dt][0] + o[dt][1] * o[dt][1]) + (o[dt][2] * o[dt][2] + o[dt][3] * o[dt][3]); }
        vr = sum_x16(vr); vr = sum_x32(vr);
        const float rstd = 1.0f / sqrtf(vr * (1.0f / 64.0f) + EPS);
#pragma unroll
        for (int dt = 0; dt < 4; ++dt) { const u32x2 g_ = gq[dir][dt];
            const f32x4 gv = (f32x4){bflo(g_.x), bfhi(g_.x), bflo(g_.y), bfhi(g_.y)};
#pragma unroll
            for (int r = 0; r < 4; ++r) res[dt][r] += o[dt][r] * rstd * silu_f(gv[r]); }
    }
    bf16_t* op = F.MIX() + (size_t)qrow * D + 256 + h * 64 + 4 * fq;
#pragma unroll
    for (int dt = 0; dt < 4; ++dt) { u32x2 w; w.x = pk2(res[dt][0], res[dt][1]); w.y = pk2(res[dt][2], res[dt][3]); *(u32x2*)(op + dt * 16) = w; }
}
__device__ __forceinline__ void p4_readout(Frame& F, int l) {
    const int u0 = (l == DEPTH - 1) ? 2 : 0, nu = NCHUNK - u0;
    for (int it = F.bid; it < BATCH * 4 * nu; it += F.G) { const int u = u0 + it % nu, bh = it / nu; p4_ret_item(F, l, bh >> 2, bh & 3, u); }
    if (l != DEPTH - 1) {
        const int nit = BATCH * 4 * nu, nmax = (nit + F.G - 1) / F.G; int nfull = nit - (nmax - 1) * F.G; if (nfull >= F.G) nfull = 0;
        if (F.bid >= nfull) p3_conv(F, l, (F.bid - nfull) * NWAVES + F.wave, (F.G - nfull) * NWAVES);
    }
}

constexpr int NK = 8;
constexpr int NPHASE = 2 + NK * DEPTH;
#ifndef PH_EN
#define PH_EN(k) 1
#endif
#ifndef PH_REP
#define PH_REP(k) 1
#endif

__global__ void __launch_bounds__(NTHREADS, 2) fwd_kernel(Args args) {
    extern __shared__ __attribute__((aligned(16))) unsigned char lds[];
    for (int u = threadIdx.x; u < (LDS_BYTES - LDSCTL_OFF) / 4; u += NTHREADS) ((LAS unsigned*)((LAS unsigned char*)lds + LDSCTL_OFF))[u] = 0u;
    __syncthreads();
    const int wslot = __builtin_amdgcn_readfirstlane((int)(threadIdx.x >> 6));
    const int lo = args.ph_lo, hi = args.ph_hi;
    volatile LAS unsigned* MISC = (volatile LAS unsigned*)((LAS unsigned char*)lds + MISC_OFF);
    XcdBarrier bar; bar.bar = (unsigned*)(args.ws + WS_CTL) + CW_BAR; bar.x = 0; bar.st = MISC + 8;
    if (hi - lo > 1) bar = xcd_barrier_post((unsigned*)(args.ws + WS_CTL) + CW_BAR, MISC + 8, wslot == 0 && __builtin_amdgcn_mbcnt_hi(~0u, __builtin_amdgcn_mbcnt_lo(~0u, 0u)) == 0);
    int ph = lo, rep = 0;
    while (ph < hi) {
        Frame F;
        F.lds = (LAS unsigned char*)lds;
        unsigned allm = ~0u; asm volatile("" : "+s"(allm));
        int ptid = wslot * 64 + (int)__builtin_amdgcn_mbcnt_hi(allm, __builtin_amdgcn_mbcnt_lo(allm, 0u)), pbid = blockIdx.x;
        F.ws = args.ws; F.ap = (const Args*)(uintptr_t)__builtin_amdgcn_kernarg_segment_ptr();
        asm volatile("" : "+s"(F.ws), "+s"(F.ap), "+v"(ptid), "+s"(pbid));
        F.tid = ptid; F.lane = ptid & 63; F.wave = __builtin_amdgcn_readfirstlane(ptid >> 6); F.bid = pbid;
        F.G = gridDim.x; F.vcu = (F.G % 8 == 0) ? (pbid % 8) * (F.G / 8) + pbid / 8 : pbid;
        const int kind = (ph == 0) ? 10 : (ph == NPHASE - 1) ? 0 : (ph - 1) % NK;
        int nrep = PH_REP(0);
#pragma unroll
        for (int kk = 1; kk <= 10; ++kk) if (kind == kk) nrep = PH_REP(kk);
        if (ph == 0) { if (PH_EN(10)) p0_prologue(F); }
        else if (ph == NPHASE - 1) { if (PH_EN(0)) p1_rows<false>(F, DEPTH); }
        else {
            const int l = (ph - 1) / NK, k = (ph - 1) % NK;
            const bool lastl = (l == DEPTH - 1);
            if (k == 0) { if (PH_EN(0)) { if (l <= 1) p1_rows<true>(F, l); else p1_rows<false>(F, l); } }
            else if (k == 1) { if (PH_EN(1)) {
                SchedDense S{MROWS / 256, INW / 256, (MROWS / 256) * (INW / 256), F.G, F.bid, (const char*)F.H(), (const char*)(F.WIN() + (size_t)l * INW * 1024), 1024};
                LAS float* lrope = (LAS float*)(F.lds + LDSCTL_OFF + 1024);
                ((LAS f32x4*)lrope)[F.tid] = ((const f32x4*)F.ROPE())[F.tid];
                __syncthreads();
                EpiIn E{F.PROJ(), lrope};
                pg8::gemm_phase(F.lds, F.tid, 1024, S, E);
            } }
            else if (k == 2) { if (PH_EN(2)) p3_mix(F, l); }
            else if (k == 3) { if (PH_EN(3)) p3b_scan(F, l); }
            else if (k == 4) { if (PH_EN(4)) p4_readout(F, l); }
            else if (k == 5) { if (PH_EN(5)) {
                unsigned* cnt5 = F.ctl() + CW_C5 + l * 128 * 64;
                SchedOut S{256, F.G, F.bid, (const char*)F.MIX(), (const char*)(F.WOUT() + (size_t)l * 1024 * 1024), cnt5};
                EpiOut E{Y1buf(F), F.MOD() + (size_t)l * 5 * 6144};
#ifndef OUT_REP
#define OUT_REP 1
#endif
#ifndef ROWS2_REP
#define ROWS2_REP 1
#endif
                for (int rr = 0; rr < OUT_REP; ++rr) pg8::gemm_phase(F.lds, F.tid, 1024, S, E);
                if (!lastl) p5_ctx_piece(F, l, cnt5);
                for (int rr = 0; rr < ROWS2_REP; ++rr) { if (rr) __syncthreads(); if (l == 0) p6_rows<true>(F, l, cnt5); else p6_rows<false>(F, l, cnt5); }
            } }
            else if (k == 6) { if (PH_EN(6)) p7_topk(F, l); }
            else { if (PH_EN(7)) {
                const int nM = lastl ? 8 : 9;
                constexpr size_t ESZ = FFN_FP8 ? 1 : 2;
                LAS int* lrows = (LAS int*)(F.lds + LDSCTL_OFF + 1024);
                SchedFfn S{nM, NE * nM * 8, NE * nM * 4, F.G, F.bid, (const char*)F.H(), (const char*)F.ACT(), (const char*)F.WGU() + (size_t)l * NE * 2048 * 1024 * ESZ, (const char*)F.WD() + (size_t)l * NE * 1024 * 1024 * ESZ,
                           lrows, F.ctl() + CW_C8 + l * 144 * 64};
                { pg8::Unit pu_; for (int i = 0; i < 5 && S.next(i, pu_); ++i) if ((pu_.t & 1) == 0 && F.tid < 256) lrows[i * 256 + F.tid] = F.ROWS()[pu_.e * EROWS + pu_.pm * 256 + F.tid]; }
                __syncthreads();
                EpiFfn E{(void*)F.ACT(), F.YB(), F.GATE()};
                pg8::gemm_phase(F.lds, F.tid, FFN_FP8 ? 512 : 1024, S, E);
            } }
        }
        if (++rep >= nrep) { rep = 0; ++ph; }
        if (ph < hi) xcd_barrier(bar, F.tid == 0);
    }
}

extern "C" void kernel_launch(void* const* d_in, const int* in_sizes, int n_in, void* d_out, int out_size, void* d_ws, size_t ws_size, hipStream_t stream) {
    static int grid = 0;
    if (grid == 0) {
        if (n_in != 18 || in_sizes[0] != NLAT * D || out_size != NLAT * D || ws_size < WS_END) {
            fprintf(stderr, "kernel_launch: unexpected shapes (n_in %d, in0 %d, out %d, ws %zu; need ws >= %zu); nothing launched\n", n_in, n_in > 0 ? in_sizes[0] : -1, out_size, ws_size, (size_t)WS_END);
            grid = -1; return; }
        int dev = 0, cus = 0, per_cu = 0;
        if (hipGetDevice(&dev) != hipSuccess || hipDeviceGetAttribute(&cus, hipDeviceAttributeMultiprocessorCount, dev) != hipSuccess) { grid = -1; return; }
        if (hipFuncSetAttribute((const void*)fwd_kernel, hipFuncAttributeMaxDynamicSharedMemorySize, LDS_BYTES) != hipSuccess) { fprintf(stderr, "kernel_launch: hipFuncSetAttribute failed\n"); grid = -1; return; }
        if (hipOccupancyMaxActiveBlocksPerMultiprocessor(&per_cu, (const void*)fwd_kernel, NTHREADS, LDS_BYTES) != hipSuccess || per_cu < 1)
            fprintf(stderr, "kernel_launch: note: occupancy query reports %d workgroups per CU\n", per_cu);
        (void)hipGetLastError();
        grid = cus;
    }
    if (grid < 0) return;
    if (hipMemsetAsync((char*)d_ws + WS_CTL, 0, CTL_ZERO_BYTES, stream) != hipSuccess) { fprintf(stderr, "kernel_launch: memset failed\n"); return; }
    Args a{};
    for (int i = 0; i < 18; ++i) a.in[i] = (const float*)d_in[i];
    a.out = (float*)d_out; a.ws = (unsigned char*)d_ws;
#if MK_PER_PHASE
    for (int ph = 0; ph < NPHASE; ++ph) {
        a.ph_lo = ph; a.ph_hi = ph + 1;
        hipLaunchKernelGGL(fwd_kernel, dim3(grid), dim3(NTHREADS), LDS_BYTES, stream, a);
    }
#else
    a.ph_lo = 0; a.ph_hi = NPHASE;
    void* kargs[] = {&a};
    hipError_t e = hipLaunchCooperativeKernel((const void*)fwd_kernel, dim3(grid), dim3(NTHREADS), kargs, LDS_BYTES, stream);
    if (e != hipSuccess) fprintf(stderr, "kernel_launch: cooperative launch failed: %s (grid %d)\n", hipGetErrorString(e), grid);
#endif
}
```
